# Optimizing an MI355X kernel written in HIP

```python
import math
import jax, jax.numpy as jnp
from jax import lax
import numpy as np

D_MODEL = 1024
BATCH = 4
SEQ = 8192
DEPTH = 2

GRID_W = 64
CTX_LEN = 256
HEAD_DIM = 64
ROPE_BASE = 10000.0
Q_BLOCK = 128
EPS = 1e-6
BRANCH_WIDTH = D_MODEL // 2
N_BRANCH = 3
A_HEADS = BRANCH_WIDTH // HEAD_DIM
A_KV_HEADS = A_HEADS // 4
A_GROUP = A_HEADS // A_KV_HEADS
S5_CH_PER_GROUP = 16
S5_STATE = 64
S5_GROUPS = BRANCH_WIDTH // S5_CH_PER_GROUP
C_HEADS = BRANCH_WIDTH // (2 * HEAD_DIM)
C_VDIM = 2 * HEAD_DIM
D_FF = 2816
IN_SIZES = (A_HEADS * HEAD_DIM, A_KV_HEADS * HEAD_DIM, A_KV_HEADS * HEAD_DIM, BRANCH_WIDTH,
            2 * C_HEADS * HEAD_DIM, 2 * C_HEADS * HEAD_DIM, C_HEADS * C_VDIM, N_BRANCH * D_MODEL)
IN_SPLITS = tuple(int(s) for s in np.cumsum(IN_SIZES)[:-1])
N_IN = int(sum(IN_SIZES))

kernel_name = "hybrid_gqa_s5_diffattn_convffn_dit"


def rms_norm(x, gain):
    xf = x.astype(jnp.float32)
    y = xf * lax.rsqrt(jnp.mean(xf * xf, axis=-1, keepdims=True) + EPS)
    return (y * gain.astype(jnp.float32)).astype(x.dtype)


def modulate(h, shift, scale):
    return h * (1.0 + scale) + shift


def axial_rope_tables(n_tokens, dtype):
    rows = n_tokens // GRID_W
    row = jnp.repeat(jnp.arange(rows, dtype=jnp.float32), GRID_W)
    col = jnp.tile(jnp.arange(GRID_W, dtype=jnp.float32), rows)
    n_freq = HEAD_DIM // 4
    inv_freq = ROPE_BASE ** (-jnp.arange(n_freq, dtype=jnp.float32) / n_freq)
    ang = jnp.concatenate([row[:, None] * inv_freq, col[:, None] * inv_freq], axis=-1)
    ang = jnp.concatenate([ang, ang], axis=-1)
    return jnp.cos(ang).astype(dtype)[:, None, :], jnp.sin(ang).astype(dtype)[:, None, :]


def apply_rope(x, cos, sin):
    half = HEAD_DIM // 2
    rot = jnp.concatenate([-x[..., half:], x[..., :half]], axis=-1)
    return x * cos + rot * sin


def sweep_query_blocks(attend, *qs):
    b, n = qs[0].shape[:2]
    nb = n // Q_BLOCK
    blocks = tuple(jnp.swapaxes(q.reshape(b, nb, Q_BLOCK, *q.shape[2:]), 0, 1) for q in qs)
    out = lax.map(lambda blk: attend(*blk), blocks)
    return jnp.swapaxes(out, 0, 1).reshape(b, n, *out.shape[3:])


def gqa_attend(q, k, v):
    s = jnp.einsum('btkgd,bskd->bkgts', q, k).astype(jnp.float32) * (HEAD_DIM ** -0.5)
    p = jax.nn.softmax(s, axis=-1).astype(v.dtype)
    return jnp.einsum('bkgts,bskd->btkgd', p, v)


def diff_attend(q1, q2, k1, k2, v, lam):
    scale = HEAD_DIM ** -0.5
    p1 = jax.nn.softmax(jnp.einsum('bthd,bshd->bhts', q1, k1).astype(jnp.float32) * scale, axis=-1)
    p2 = jax.nn.softmax(jnp.einsum('bthd,bshd->bhts', q2, k2).astype(jnp.float32) * scale, axis=-1)
    p = (p1 - lam * p2).astype(v.dtype)
    return jnp.einsum('bhts,bshe->bthe', p, v)


def heads(t, n_heads, dim):
    return t.reshape(t.shape[0], t.shape[1], n_heads, dim)


def gqa_mixer(q, k, v, qc, kc, vc, g_q, g_k, cos, sin, ctx_out):
    b, n = q.shape[:2]
    q = apply_rope(rms_norm(heads(q, A_HEADS, HEAD_DIM), g_q), cos, sin)
    q = q.reshape(b, n, A_KV_HEADS, A_GROUP, HEAD_DIM)
    k = apply_rope(rms_norm(heads(k, A_KV_HEADS, HEAD_DIM), g_k), cos, sin)
    v = heads(v, A_KV_HEADS, HEAD_DIM)
    kc = rms_norm(heads(kc, A_KV_HEADS, HEAD_DIM), g_k)
    vc = heads(vc, A_KV_HEADS, HEAD_DIM)
    k_all = jnp.concatenate([kc, k], axis=1)
    v_all = jnp.concatenate([vc, v], axis=1)
    y = sweep_query_blocks(lambda qb: gqa_attend(qb, k_all, v_all), q).reshape(b, n, BRANCH_WIDTH)
    yc = None
    if ctx_out:
        nc = qc.shape[1]
        qc = rms_norm(heads(qc, A_HEADS, HEAD_DIM), g_q).reshape(b, nc, A_KV_HEADS, A_GROUP, HEAD_DIM)
        yc = gqa_attend(qc, kc, vc).reshape(b, nc, BRANCH_WIDTH)
    return y, yc


def diff_mixer(q, k, v, qc, kc, vc, g_q, g_k, lam_vecs, g_out, lam_init, cos, sin, ctx_out):
    def split_qk(t, gain, rope):
        b, n = t.shape[:2]
        t = rms_norm(heads(t, 2 * C_HEADS, HEAD_DIM), gain)
        if rope:
            t = apply_rope(t, cos, sin)
        t = t.reshape(b, n, C_HEADS, 2, HEAD_DIM)
        return t[..., 0, :], t[..., 1, :]

    lv = lam_vecs.astype(jnp.float32)
    lam = jnp.exp(jnp.sum(lv[0] * lv[1])) - jnp.exp(jnp.sum(lv[2] * lv[3])) + lam_init

    def finish(o):
        o = rms_norm(o, g_out) * (1.0 - lam_init)
        return o.reshape(o.shape[0], o.shape[1], BRANCH_WIDTH)

    q1, q2 = split_qk(q, g_q, True)
    k1, k2 = split_qk(k, g_k, True)
    kc1, kc2 = split_qk(kc, g_k, False)
    v = heads(v, C_HEADS, C_VDIM)
    vc = heads(vc, C_HEADS, C_VDIM)
    k1_all = jnp.concatenate([kc1, k1], axis=1)
    k2_all = jnp.concatenate([kc2, k2], axis=1)
    v_all = jnp.concatenate([vc, v], axis=1)
    y = finish(sweep_query_blocks(lambda a, b_: diff_attend(a, b_, k1_all, k2_all, v_all, lam), q1, q2))
    yc = None
    if ctx_out:
        qc1, qc2 = split_qk(qc, g_q, False)
        yc = finish(diff_attend(qc1, qc2, kc1, kc2, vc, lam))
    return y, yc


def zoh(lam_re, lam_im, log_dt, b_re, b_im):
    dt = jnp.exp(log_dt)[:, None]
    mag = jnp.exp(lam_re * dt)
    a_re = mag * jnp.cos(lam_im * dt)
    a_im = mag * jnp.sin(lam_im * dt)
    den = lam_re * lam_re + lam_im * lam_im
    f_re = ((a_re - 1.0) * lam_re + a_im * lam_im) / den
    f_im = (a_im * lam_re - (a_re - 1.0) * lam_im) / den
    bb_re = f_re[..., None] * b_re - f_im[..., None] * b_im
    bb_im = f_re[..., None] * b_im + f_im[..., None] * b_re
    return a_re, a_im, bb_re, bb_im


def complex_linear_scan(a_re, a_im, b_re, b_im):
    n = b_re.shape[1]
    a_re_t = jnp.broadcast_to(a_re, (1, n) + a_re.shape)
    a_im_t = jnp.broadcast_to(a_im, (1, n) + a_im.shape)

    def combine(earlier, later):
        ar, ai, br, bi = earlier
        cr, ci, dr, di = later
        return (cr * ar - ci * ai, cr * ai + ci * ar,
                cr * br - ci * bi + dr, cr * bi + ci * br + di)

    _, _, x_re, x_im = lax.associative_scan(combine, (a_re_t, a_im_t, b_re, b_im), axis=1)
    return x_re, x_im


def s5_direction(u, uc, a_re, a_im, bb_re, bb_im, c_re, c_im, reverse, ctx_out):
    def flip(t):
        return jnp.flip(t, axis=1) if reverse else t

    def drive(t):
        return (jnp.einsum('blgc,gpc->blgp', t, bb_re), jnp.einsum('blgc,gpc->blgp', t, bb_im))

    def readout(xr, xi):
        return jnp.einsum('blgp,gcp->blgc', xr, c_re) - jnp.einsum('blgp,gcp->blgc', xi, c_im)

    bc_re, bc_im = drive(flip(uc))
    xc_re, xc_im = complex_linear_scan(a_re, a_im, bc_re, bc_im)
    s_re, s_im = xc_re[:, -1], xc_im[:, -1]
    b_re, b_im = drive(flip(u))
    b_re = b_re.at[:, 0].add(a_re * s_re - a_im * s_im)
    b_im = b_im.at[:, 0].add(a_re * s_im + a_im * s_re)
    x_re, x_im = complex_linear_scan(a_re, a_im, b_re, b_im)
    y = flip(readout(x_re, x_im))
    yc = flip(readout(xc_re, xc_im)) if ctx_out else None
    return y, yc


def s5_mixer(u, uc, lam_re, lam_im, log_dt, b_re, b_im, c_re, c_im, d_skip, w_glu, b_glu, ctx_out):
    dtype = u.dtype
    f = lambda t: t.astype(jnp.float32)
    to_groups = lambda t: f(t).reshape(t.shape[0], t.shape[1], S5_GROUPS, S5_CH_PER_GROUP)
    ug, ucg = to_groups(u), to_groups(uc)
    outs = [s5_direction(ug, ucg, *zoh(f(lam_re[d]), f(lam_im[d]), f(log_dt[d]), f(b_re[d]), f(b_im[d])),
                         f(c_re[d]), f(c_im[d]), reverse=(d == 1), ctx_out=ctx_out)
            for d in range(2)]
    d_g = f(d_skip).reshape(S5_GROUPS, S5_CH_PER_GROUP)

    def glu(y, ugr):
        y = y + d_g * ugr
        g = jax.nn.gelu(y.reshape(y.shape[0], y.shape[1], BRANCH_WIDTH))
        return (g * jax.nn.sigmoid(g @ f(w_glu) + f(b_glu))).astype(dtype)

    y = glu(outs[0][0] + outs[1][0], ug)
    yc = glu(outs[0][1] + outs[1][1], ucg) if ctx_out else None
    return y, yc


def merge_branches(gate_logits, ya, yb, yc, w_branch, w_out):
    g = jax.nn.sigmoid(gate_logits.reshape(*gate_logits.shape[:-1], N_BRANCH, D_MODEL))
    m = (g[..., 0, :] * (ya @ w_branch[0]) + g[..., 1, :] * (yb @ w_branch[1])
         + g[..., 2, :] * (yc @ w_branch[2]))
    return m @ w_out


def hybrid_mixer(h, hc, w_in, qk_gain, lam_re, lam_im, log_dt, b_re, b_im, c_re, c_im, d_skip,
                 w_glu, b_glu, diff_lam, diff_norm_g, w_branch, w_out, lam_init, cos, sin, ctx_out):
    z = jnp.split(h @ w_in, IN_SPLITS, axis=-1)
    zc = jnp.split(hc @ w_in, IN_SPLITS, axis=-1)
    ya, yca = gqa_mixer(z[0], z[1], z[2], zc[0], zc[1], zc[2], qk_gain[0], qk_gain[1], cos, sin, ctx_out)
    yb, ycb = s5_mixer(z[3], zc[3], lam_re, lam_im, log_dt, b_re, b_im, c_re, c_im, d_skip,
                       w_glu, b_glu, ctx_out)
    yd, ycd = diff_mixer(z[4], z[5], z[6], zc[4], zc[5], zc[6], qk_gain[2], qk_gain[3], diff_lam,
                         diff_norm_g, lam_init, cos, sin, ctx_out)
    y = merge_branches(z[7], ya, yb, yd, w_branch, w_out)
    yc = merge_branches(zc[7], yca, ycb, ycd, w_branch, w_out) if ctx_out else None
    return y, yc


def dwconv3(u, w, b):
    up = jnp.pad(u, ((0, 0), (1, 1), (0, 0)))
    return up[:, :-2] * w[0] + up[:, 1:-1] * w[1] + up[:, 2:] * w[2] + b


def conv_ffn(h, w_up, conv_w, conv_b, w_down):
    u = dwconv3(h @ w_up, conv_w, conv_b)
    a, g = jnp.split(u, 2, axis=-1)
    return (jax.nn.silu(g) * a) @ w_down


def setup_inputs(seed: int = 0) -> dict:
    key = jax.random.key(seed)
    ks = jax.random.split(key, 32)
    f32 = jnp.float32
    nrm = lambda k, shape, scale: jax.random.normal(k, shape, f32) * scale
    G, P, C = S5_GROUPS, S5_STATE, S5_CH_PER_GROUP
    lam_im_base = math.pi * jnp.arange(P, dtype=f32)
    return {
        "x": nrm(ks[0], (BATCH, SEQ, D_MODEL), 1.0),
        "c": nrm(ks[1], (BATCH, D_MODEL), 1.0),
        "ctx": nrm(ks[2], (BATCH, CTX_LEN, D_MODEL), 1.0),
        "c_ctx": nrm(ks[3], (D_MODEL,), 1.0),
        "w_ada": nrm(ks[4], (DEPTH, D_MODEL, 6 * D_MODEL), 0.5 * D_MODEL ** -0.5),
        "b_ada": nrm(ks[5], (DEPTH, 6 * D_MODEL), 0.02),
        "norm_g": 1.0 + nrm(ks[6], (DEPTH, 2, D_MODEL), 0.05),
        "w_in": nrm(ks[7], (DEPTH, D_MODEL, N_IN), D_MODEL ** -0.5),
        "qk_gain": 1.0 + nrm(ks[8], (DEPTH, 4, HEAD_DIM), 0.05),
        "ssm_lam_re": -0.5 + nrm(ks[9], (DEPTH, 2, G, P), 0.01),
        "ssm_lam_im": lam_im_base + nrm(ks[10], (DEPTH, 2, G, P), 0.01),
        "ssm_log_dt": jax.random.uniform(ks[11], (DEPTH, 2, G), f32, math.log(1e-3), math.log(1e-1)),
        "ssm_b_re": nrm(ks[12], (DEPTH, 2, G, P, C), (2 * C) ** -0.5),
        "ssm_b_im": nrm(ks[13], (DEPTH, 2, G, P, C), (2 * C) ** -0.5),
        "ssm_c_re": nrm(ks[14], (DEPTH, 2, G, C, P), (2 * P) ** -0.5),
        "ssm_c_im": nrm(ks[15], (DEPTH, 2, G, C, P), (2 * P) ** -0.5),
        "ssm_d": nrm(ks[16], (DEPTH, BRANCH_WIDTH), 0.5),
        "w_glu": nrm(ks[17], (DEPTH, BRANCH_WIDTH, BRANCH_WIDTH), BRANCH_WIDTH ** -0.5),
        "b_glu": nrm(ks[18], (DEPTH, BRANCH_WIDTH), 0.02),
        "diff_lam": nrm(ks[19], (DEPTH, 4, HEAD_DIM), 0.1),
        "diff_norm_g": 1.0 + nrm(ks[20], (DEPTH, C_VDIM), 0.05),
        "w_branch": nrm(ks[21], (DEPTH, N_BRANCH, BRANCH_WIDTH, D_MODEL), BRANCH_WIDTH ** -0.5),
        "w_out": nrm(ks[22], (DEPTH, D_MODEL, D_MODEL), D_MODEL ** -0.5),
        "w_up": nrm(ks[23], (DEPTH, D_MODEL, 2 * D_FF), D_MODEL ** -0.5),
        "conv_w": nrm(ks[24], (DEPTH, 3, 2 * D_FF), 3 ** -0.5),
        "conv_b": nrm(ks[25], (DEPTH, 2 * D_FF), 0.02),
        "w_down": nrm(ks[26], (DEPTH, D_FF, D_MODEL), D_FF ** -0.5),
    }


def reference(x, c, ctx, c_ctx, w_ada, b_ada, norm_g, w_in, qk_gain, ssm_lam_re, ssm_lam_im,
              ssm_log_dt, ssm_b_re, ssm_b_im, ssm_c_re, ssm_c_im, ssm_d, w_glu, b_glu, diff_lam,
              diff_norm_g, w_branch, w_out, w_up, conv_w, conv_b, w_down):
    cos, sin = axial_rope_tables(x.shape[1], x.dtype)
    xc = ctx
    for i in range(DEPTH):
        last = i == DEPTH - 1
        lam_init = 0.8 - 0.6 * math.exp(-0.3 * i)
        mod = jnp.split((jax.nn.silu(c) @ w_ada[i] + b_ada[i])[:, None, :], 6, axis=-1)
        modc = jnp.split(jax.nn.silu(c_ctx) @ w_ada[i] + b_ada[i], 6, axis=-1)
        h = modulate(rms_norm(x, norm_g[i, 0]), mod[0], mod[1])
        hc = modulate(rms_norm(xc, norm_g[i, 0]), modc[0], modc[1])
        y, yc = hybrid_mixer(h, hc, w_in[i], qk_gain[i], ssm_lam_re[i], ssm_lam_im[i], ssm_log_dt[i],
                             ssm_b_re[i], ssm_b_im[i], ssm_c_re[i], ssm_c_im[i], ssm_d[i], w_glu[i],
                             b_glu[i], diff_lam[i], diff_norm_g[i], w_branch[i], w_out[i], lam_init,
                             cos, sin, ctx_out=not last)
        x = x + mod[2] * y
        h = modulate(rms_norm(x, norm_g[i, 1]), mod[3], mod[4])
        x = x + mod[5] * conv_ffn(h, w_up[i], conv_w[i], conv_b[i], w_down[i])
        if not last:
            xc = xc + modc[2] * yc
            hc = modulate(rms_norm(xc, norm_g[i, 1]), modc[3], modc[4])
            xc = xc + modc[5] * conv_ffn(hc, w_up[i], conv_w[i], conv_b[i], w_down[i])
    return x
```

```cpp
#include <hip/hip_runtime.h>
#include <hip/hip_cooperative_groups.h>
#include <cstdio>
#include <cstdint>
namespace cg = cooperative_groups;

#ifndef N_LAUNCH_MODE
#define N_LAUNCH_MODE 1
#endif

#define LAS __attribute__((address_space(3)))
typedef unsigned short bf16_t;
typedef short bf16x8 __attribute__((ext_vector_type(8)));
typedef short s16x4 __attribute__((ext_vector_type(4)));
typedef float f32x4 __attribute__((ext_vector_type(4)));
typedef float f32x2 __attribute__((ext_vector_type(2)));
typedef float f32x16 __attribute__((ext_vector_type(16)));
typedef unsigned u32x4 __attribute__((ext_vector_type(4)));
typedef unsigned u32x2 __attribute__((ext_vector_type(2)));

constexpr int DM = 1024, NBATCH = 4, SEQ = 8192, CTXL = 256;
constexpr int NLAT = NBATCH * SEQ, NCTX = NBATCH * CTXL, MT = NLAT + NCTX;
constexpr int DFF = 2816, NIN = 5888, NMIX = 2816;
constexpr int NCHUNK = MT / 32, CHPAD = 1280;
constexpr float EPS = 1e-6f;
constexpr float QSCALE = 0.125f * 1.4426950408889634f;

constexpr size_t MiB = 1u << 20;
constexpr size_t WS_MOD = 0;
constexpr size_t WS_BAR = 384 * 1024;
constexpr size_t WS_TAB = 512 * 1024;
constexpr size_t WS_W = 1 * MiB;
constexpr size_t W_WIN = 0, W_BCAT = W_WIN + (size_t)2816 * 1024 * 2, W_GLU = W_BCAT + (size_t)3 * 1024 * 1536 * 2, W_OUT = W_GLU + (size_t)512 * 512 * 2,
                 W_UP = W_OUT + (size_t)1024 * 1024 * 2, W_DOWN = W_UP + (size_t)5632 * 1024 * 2, W_M1 = W_DOWN + (size_t)1024 * 2816 * 2,
                 W_TM2 = W_M1 + (size_t)32 * 256 * 512 * 2, W_END = W_TM2 + (size_t)32 * 512 * 768 * 2;
static_assert(W_END <= 66 * MiB, "weights");
constexpr size_t WS_H = 67 * MiB;
constexpr size_t WS_XC = 133 * MiB;
constexpr size_t WS_AR = 137 * MiB;
constexpr size_t AR_YAB = 0, AR_YD = 66 * MiB, AR_KA = 132 * MiB, AR_VA = 141 * MiB, AR_KC = 150 * MiB, AR_VC = 183 * MiB, AR_UC = 216 * MiB, AR_S = 276 * MiB, AR_END = 316 * MiB;
constexpr size_t AR_O1 = 216 * MiB;
constexpr size_t AR_M = 132 * MiB, AR_SM = 198 * MiB, AR_SG = 262 * MiB;
constexpr size_t AR_ACT = 0, AR_UB = 188 * MiB, AR_HB = 204 * MiB;
constexpr size_t AR_PART = 208 * MiB;
constexpr size_t AR_MCTX = 296 * MiB, AR_PG4 = 302 * MiB;
constexpr int NBGRP = 265;
constexpr size_t WS_TOTAL = WS_AR + AR_END;
static_assert((size_t)32 * CHPAD * 768 * 2 <= 60 * MiB && (size_t)32 * CHPAD * 256 * 4 <= 40 * MiB, "s5 buffers");
static_assert((size_t)MT * 2816 * 2 <= 188 * MiB && AR_UB + (size_t)1280 * 5632 * 2 <= AR_HB && AR_HB + (size_t)1280 * 1024 * 2 <= AR_END, "ffn buffers");

struct Params {
    const float* in[27];
    float* out; unsigned char* ws;
    int ph_lo, ph_hi, rep_q, rep_n;
};

typedef __bf16 bf16x2_t __attribute__((ext_vector_type(2)));
__device__ __forceinline__ unsigned cvt_pk_bf16(float lo, float hi) { f32x2 v = {lo, hi}; bf16x2_t b = __builtin_convertvector(v, bf16x2_t); return __builtin_bit_cast(unsigned, b); }
__device__ __forceinline__ float bf2f(unsigned short b) { return __uint_as_float((unsigned)b << 16); }
__device__ __forceinline__ float bflo(unsigned w) { return __uint_as_float(w << 16); }
__device__ __forceinline__ float bfhi(unsigned w) { return __uint_as_float(w & 0xffff0000u); }
__device__ __forceinline__ float sigmoidf_(float v) { return __builtin_amdgcn_rcpf(1.0f + __builtin_amdgcn_exp2f(-1.4426950408889634f * v)); }
__device__ __forceinline__ float gelu_tanh(float y) { const float u = 1.5957691216057308f * (y + 0.044715f * y * y * y); return y * sigmoidf_(u); }
template <int K> __device__ __forceinline__ float shx(float v) {
    return __uint_as_float((unsigned)__builtin_amdgcn_ds_swizzle((int)__float_as_uint(v), (K << 10) | 0x1f));
}
__device__ __forceinline__ float sum_x32(float v) { auto rr = __builtin_amdgcn_permlane32_swap(__float_as_uint(v), __float_as_uint(v), false, false); return __uint_as_float(rr[0]) + __uint_as_float(rr[1]); }
__device__ __forceinline__ float max_x32(float v) { auto rr = __builtin_amdgcn_permlane32_swap(__float_as_uint(v), __float_as_uint(v), false, false); return fmaxf(__uint_as_float(rr[0]), __uint_as_float(rr[1])); }
__device__ __forceinline__ float wave_sum(float v) {
    v += shx<1>(v); v += shx<2>(v); v += shx<4>(v); v += shx<8>(v); v += shx<16>(v); return sum_x32(v);
}
__device__ __forceinline__ float wave_max(float v) {
    v = fmaxf(v, shx<1>(v)); v = fmaxf(v, shx<2>(v)); v = fmaxf(v, shx<4>(v)); v = fmaxf(v, shx<8>(v)); v = fmaxf(v, shx<16>(v)); return max_x32(v);
}

namespace pg8 {
constexpr int BM = 256, BK = 64, HALF = 128, HTB = HALF * BK * 2, STAGE_BYTES = 8 * HTB, WGM = 4;
__host__ __device__ __forceinline__ int lds_byte(int r, int c) { const int st = (r >> 4) * 2 + (c >> 5), rr = r & 15, cc = c & 31, ob = rr * 64 + cc * 2; return st * 1024 + (ob ^ (((ob >> 9) & 1) << 5)); }
__host__ __device__ __forceinline__ void stage_rc(int b, int& R, int& C) { const int st = b / 1024, sb = b % 1024, swz = sb ^ (((sb >> 9) & 1) << 5); R = (st >> 1) * 16 + swz / 64; C = (st & 1) * 32 + (swz % 64) / 2; }

struct Unit { const bf16_t* A; const bf16_t* B; int nt; int pm; int pn; int mode; };

__device__ __forceinline__ bool tile_of(int L, int nM, int nN, int& pm, int& pn) {
    const int nwg = nM * nN; if (L >= nwg) return false;
    int wgid = (int)L; { const int q = nwg / 8, r = nwg % 8, xcd = wgid % 8, off = wgid / 8; wgid = (xcd < r ? xcd * (q + 1) : r * (q + 1) + (xcd - r) * q) + off; }
    const int nig = WGM * nN, gid = wgid / nig, fm = gid * WGM, gsz = (nM - fm) < WGM ? (nM - fm) : WGM;
    pm = fm + ((wgid % nig) % gsz); pn = (wgid % nig) / gsz; return true;
}

template <class Epi, class Sched, bool ALIGN_EPI, bool SP2, bool PERMA = false>
__device__ __forceinline__ void gemm_phase(LAS unsigned char* lds, const int tid, const int lda, const int ldb, const Sched& S, const Epi& E) {
    const int wid = __builtin_amdgcn_readfirstlane(tid >> 6), lane = tid & 63, wr = wid >> 2, wc = wid & 3, fr = lane & 15, fq = lane >> 4;
    unsigned voffA[2], voffB[2];
#pragma unroll
    for (int i = 0; i < 2; ++i) { int R, C; stage_rc(tid * 16 + i * 8192, R, C);
        const int Ra = PERMA ? (128 * (R >> 6) + 8 * (R & 15) + ((R >> 4) & 3)) : R;
        voffA[i] = (unsigned)(Ra * lda + C) * 2u; voffB[i] = (unsigned)(R * ldb + C) * 2u; }
    const size_t kstep = (size_t)(BK * 2);
    const size_t hsA = (size_t)(PERMA ? 4 : HALF) * lda * 2, hsB = (size_t)HALF * ldb * 2;
    const unsigned ldsw = (unsigned)wid * 1024u;
    const int aoff = lds_byte(wr * 64 + fr, fq * 8), boff = lds_byte(wc * 32 + fr, fq * 8);
#define PG8_SA(b, h) (((b) * 2 + (h)) * HTB)
#define PG8_SB(b, h) ((4 + (b) * 2 + (h)) * HTB)
#define PG8_STAGE(bufoff, gbase, voff) do { _Pragma("unroll") for (int _i = 0; _i < 2; ++_i) \
        __builtin_amdgcn_global_load_lds((const unsigned*)((const char*)(gbase) + (voff)[_i]), (LAS unsigned*)(lds + (bufoff) + ldsw + _i * 8192), 16, 0, 0); } while (0)
#define PG8_LDA(dst, b, h) do { _Pragma("unroll") for (int m = 0; m < 4; ++m) _Pragma("unroll") for (int k = 0; k < 2; ++k) dst[m][k] = *(const LAS bf16x8*)(lds + PG8_SA(b, h) + aoff + m * 2048 + k * 1024); } while (0)
#define PG8_LDB(dst, b, h) do { _Pragma("unroll") for (int n = 0; n < 2; ++n) _Pragma("unroll") for (int k = 0; k < 2; ++k) dst[n][k] = *(const LAS bf16x8*)(lds + PG8_SB(b, h) + boff + n * 2048 + k * 1024); } while (0)
#define PG8_MMA(ai, bj, At, Bt) do { __builtin_amdgcn_s_setprio(1); _Pragma("unroll") for (int m = 0; m < 4; ++m) _Pragma("unroll") for (int n = 0; n < 2; ++n) _Pragma("unroll") for (int k = 0; k < 2; ++k) \
        acc[ai][bj][m][n] = __builtin_amdgcn_mfma_f32_16x16x32_bf16(Bt[n][k], At[m][k], acc[ai][bj][m][n], 0, 0, 0); __builtin_amdgcn_s_setprio(0); } while (0)
#define PG8_WAIT_V(n) asm volatile("s_waitcnt vmcnt(" #n ")" ::: "memory")
#define PG8_WAIT_L(n) asm volatile("s_waitcnt lgkmcnt(" #n ")" ::: "memory")
#define PG8_BAR __builtin_amdgcn_s_barrier()
#define PG8_SCHED __builtin_amdgcn_sched_barrier(0)
    Unit cur, nxt; int ui = 0;
    if (!S.next(0, cur)) return;
    f32x4 acc[2][2][4][2];
#pragma unroll
    for (int a = 0; a < 2; ++a)
#pragma unroll
        for (int b = 0; b < 2; ++b)
#pragma unroll
            for (int m = 0; m < 4; ++m)
#pragma unroll
                for (int n = 0; n < 2; ++n) acc[a][b][m][n] = (f32x4){0.f, 0.f, 0.f, 0.f};
    bf16x8 At[4][2], B0[2][2], B1[2][2];
    const char* cA = (const char*)cur.A; const char* cB = (const char*)cur.B;
    if constexpr (SP2) {
        PG8_STAGE(PG8_SB(0, 0), cB, voffB); PG8_STAGE(PG8_SB(0, 1), cB + hsB, voffB); PG8_STAGE(PG8_SA(0, 0), cA, voffA); PG8_STAGE(PG8_SA(0, 1), cA + hsA, voffA);
        if (wr == 1) PG8_BAR;
        PG8_WAIT_V(2); PG8_BAR;
        PG8_STAGE(PG8_SB(1, 0), cB + kstep, voffB); PG8_STAGE(PG8_SA(1, 0), cA + kstep, voffA); PG8_STAGE(PG8_SB(1, 1), cB + hsB + kstep, voffB);
        PG8_WAIT_V(6); PG8_BAR;
    } else {
        PG8_STAGE(PG8_SB(0, 0), cB, voffB); PG8_STAGE(PG8_SA(0, 0), cA, voffA); PG8_STAGE(PG8_SB(0, 1), cB + hsB, voffB); PG8_STAGE(PG8_SA(0, 1), cA + hsA, voffA);
        if (wr == 1) PG8_BAR;
        PG8_WAIT_V(4); PG8_BAR;
        PG8_STAGE(PG8_SB(1, 0), cB + kstep, voffB); PG8_STAGE(PG8_SA(1, 0), cA + kstep, voffA); PG8_STAGE(PG8_SB(1, 1), cB + hsB + kstep, voffB);
        PG8_WAIT_V(6); PG8_BAR;
    }
    for (;;) {
        const bool has_next = S.next(ui + 1, nxt);
        const char* nA = has_next ? (const char*)nxt.A : cA; const char* nB = has_next ? (const char*)nxt.B : cB;
        const int nt = cur.nt;
        for (int t = 0; t < nt; t += 2) {
            const bool last = (t == nt - 2);
            const char* a1 = cA + (size_t)(t + 1) * kstep;
            const char* a2 = last ? nA : cA + (size_t)(t + 2) * kstep; const char* b2 = last ? nB : cB + (size_t)(t + 2) * kstep;
            const char* a3 = a2 + kstep; const char* b3 = b2 + kstep;
            if constexpr (SP2) {
            PG8_LDB(B0, 0, 0); PG8_LDB(B1, 0, 1); PG8_SCHED; PG8_LDA(At, 0, 0); PG8_STAGE(PG8_SA(1, 1), a1 + hsA, voffA);
            PG8_WAIT_V(8); PG8_WAIT_L(0); PG8_BAR; PG8_MMA(0, 0, At, B0); PG8_MMA(0, 1, At, B1); PG8_BAR; PG8_SCHED;
            PG8_LDA(At, 0, 1); PG8_STAGE(PG8_SB(0, 0), b2, voffB); PG8_STAGE(PG8_SB(0, 1), b2 + hsB, voffB); PG8_STAGE(PG8_SA(0, 0), a2, voffA);
            PG8_WAIT_V(8); PG8_WAIT_L(0); PG8_BAR; PG8_MMA(1, 0, At, B0); PG8_MMA(1, 1, At, B1); PG8_BAR; PG8_SCHED;
            PG8_LDB(B0, 1, 0); PG8_LDB(B1, 1, 1); PG8_SCHED; PG8_LDA(At, 1, 0); PG8_STAGE(PG8_SA(0, 1), a2 + hsA, voffA);
            PG8_WAIT_V(8); PG8_WAIT_L(0); PG8_BAR; PG8_MMA(0, 0, At, B0); PG8_MMA(0, 1, At, B1); PG8_BAR; PG8_SCHED;
            PG8_LDA(At, 1, 1); PG8_STAGE(PG8_SB(1, 0), b3, voffB); PG8_STAGE(PG8_SB(1, 1), b3 + hsB, voffB); PG8_STAGE(PG8_SA(1, 0), a3, voffA);
            PG8_WAIT_V(8); PG8_WAIT_L(0); PG8_BAR; PG8_MMA(1, 0, At, B0); PG8_MMA(1, 1, At, B1); PG8_BAR; PG8_SCHED;
            } else {
            PG8_LDB(B0, 0, 0); PG8_SCHED; PG8_LDA(At, 0, 0); PG8_STAGE(PG8_SA(1, 1), a1 + hsA, voffA);
            PG8_WAIT_L(8); PG8_BAR; PG8_WAIT_L(0); PG8_MMA(0, 0, At, B0); PG8_BAR; PG8_SCHED;
            PG8_LDB(B1, 0, 1); PG8_STAGE(PG8_SB(0, 0), b2, voffB);
            PG8_BAR; PG8_WAIT_L(0); PG8_MMA(0, 1, At, B1); PG8_BAR;
            PG8_LDA(At, 0, 1); PG8_STAGE(PG8_SA(0, 0), a2, voffA);
            PG8_BAR; PG8_WAIT_L(0); PG8_MMA(1, 0, At, B0); PG8_BAR; PG8_SCHED;
            PG8_STAGE(PG8_SB(0, 1), b2 + hsB, voffB);
            PG8_WAIT_V(6); PG8_BAR; PG8_MMA(1, 1, At, B1); PG8_BAR;
            PG8_LDB(B0, 1, 0); PG8_SCHED; PG8_LDA(At, 1, 0); PG8_STAGE(PG8_SA(0, 1), a2 + hsA, voffA);
            PG8_WAIT_L(8); PG8_BAR; PG8_WAIT_L(0); PG8_MMA(0, 0, At, B0); PG8_BAR; PG8_SCHED;
            PG8_LDB(B1, 1, 1); PG8_STAGE(PG8_SB(1, 0), b3, voffB);
            PG8_BAR; PG8_WAIT_L(0); PG8_MMA(0, 1, At, B1); PG8_BAR;
            PG8_LDA(At, 1, 1); PG8_STAGE(PG8_SA(1, 0), a3, voffA);
            PG8_BAR; PG8_WAIT_L(0); PG8_MMA(1, 0, At, B0); PG8_BAR; PG8_SCHED;
            PG8_STAGE(PG8_SB(1, 1), b3 + hsB, voffB);
            PG8_WAIT_V(6); PG8_BAR; PG8_MMA(1, 1, At, B1); PG8_BAR;
            }
        }
        if constexpr (ALIGN_EPI) { if (wr == 0) PG8_BAR; }
        { int frl = fr, fql = fq; asm volatile("" : "+v"(frl), "+v"(fql)); E(acc, cur, wr, wc, frl, fql); }
        if (!has_next) break;
#pragma unroll
        for (int a = 0; a < 2; ++a)
#pragma unroll
            for (int b = 0; b < 2; ++b)
#pragma unroll
                for (int m = 0; m < 4; ++m)
#pragma unroll
                    for (int n = 0; n < 2; ++n) acc[a][b][m][n] = (f32x4){0.f, 0.f, 0.f, 0.f};
        cur = nxt; cA = nA; cB = nB; ++ui;
        if constexpr (ALIGN_EPI) { if (wr == 1) PG8_BAR; }
    }
    PG8_WAIT_V(0);
    if constexpr (!ALIGN_EPI) { if (wr == 0) PG8_BAR; }
    PG8_BAR;
#undef PG8_SA
#undef PG8_SB
#undef PG8_STAGE
#undef PG8_LDA
#undef PG8_LDB
#undef PG8_MMA
#undef PG8_WAIT_V
#undef PG8_WAIT_L
#undef PG8_BAR
#undef PG8_SCHED
}
}
using pg8::Unit;

struct SchedPlain {
    const bf16_t* A; const bf16_t* B; int lda, ldb, nM, nN, nt, G, c, pm0;
    __device__ __forceinline__ bool next(int i, Unit& u) const {
        int pm, pn; if (!pg8::tile_of(i * G + c, nM, nN, pm, pn)) return false;
        u.A = A + (size_t)pm * 256 * lda; u.B = B + (size_t)pn * 256 * ldb; u.nt = nt; u.pm = pm0 + pm; u.pn = pn; u.mode = 0; return true;
    }
};
struct SchedS5 {
    const bf16_t* UC; const bf16_t* B; int ldb, nN, nt, G, c, nmt;
    __device__ __forceinline__ bool next(int i, Unit& u) const {
        const int L = i * G + c; if (L >= 32 * nmt * nN) return false;
        const int pn = L % nN, mt = (L / nN) % nmt, g = L / (nmt * nN);
        u.A = UC + ((size_t)g * CHPAD + 256 * mt) * 768; u.B = B + ((size_t)g * nN * 256 + (size_t)pn * 256) * ldb; u.nt = nt; u.pm = mt; u.pn = pn; u.mode = g; return true;
    }
};
struct SchedMerge {
    const bf16_t* H; const bf16_t* YAB; const bf16_t* YD; const bf16_t* Bcat; int nchain, G, c;
    __device__ __forceinline__ bool next(int i, Unit& u) const {
        const int nl = (c < 512) ? (512 - c + G - 1) / G : 0;
        int pm, pn, j, sub;
        if (i < 6 * nl) { const int ti = i / 6; sub = i - ti * 6; j = sub >> 1; pg8::tile_of(ti * G + c, 128, 4, pm, pn); u.mode = sub; }
        else { const int k = i - 6 * nl; if (k >= 2 || c >= nchain) return false;
               const int tile = c / 3; j = c - tile * 3; pm = 128 + (tile >> 2); pn = tile & 3; sub = k; u.mode = 8 + 2 * j + k; }
        const bf16_t* Bj = Bcat + (size_t)j * 1024 * 1536 + (size_t)pn * 256 * 1536;
        if ((sub & 1) == 0) { u.A = H + (size_t)pm * 256 * 1024; u.B = Bj; u.nt = 16; }
        else { const bf16_t* Y = (j == 0) ? YAB : (j == 1) ? (YAB + 512) : YD; u.A = Y + (size_t)pm * 256 * 1024; u.B = Bj + 1024; u.nt = 8; }
        u.pm = pm; u.pn = pn; return true;
    }
};
struct SchedG4 {
    const bf16_t* M; const bf16_t* MCTX; const bf16_t* B; int nchain, G, c;
    __device__ __forceinline__ bool next(int i, Unit& u) const {
        const int L = i * G + c;
        if (L < 512) { int pm, pn; pg8::tile_of(L, 128, 4, pm, pn); u.A = M + (size_t)pm * 256 * 1024; u.B = B + (size_t)pn * 256 * 1024; u.nt = 16; u.pm = pm; u.pn = pn; u.mode = 0; return true; }
        const int p = L - 512; if (p >= nchain) return false;
        const int tile = p / 3, j = p - tile * 3, pm = 128 + (tile >> 2), pn = tile & 3;
        u.A = MCTX + (size_t)j * NCTX * 1024 + (size_t)(pm - 128) * 256 * 1024; u.B = B + (size_t)pn * 256 * 1024; u.nt = 16; u.pm = pm; u.pn = pn; u.mode = 1 + j; return true;
    }
};
struct SchedG6c {
    const bf16_t* A; const bf16_t* B; int G, c, nparts;
    __device__ __forceinline__ bool next(int i, Unit& u) const {
        const int L = i * G + c;
        if (L < 512) { int pm, pn; pg8::tile_of(L, 128, 4, pm, pn); u.A = A + (size_t)pm * 256 * 2816; u.B = B + (size_t)pn * 256 * 2816; u.nt = 44; u.pm = pm; u.pn = pn; u.mode = 0; return true; }
        if (L >= 512 + nparts) return false;
        const int p = L - 512, tile = p >> 2, kp = p & 3, pm = 128 + (tile >> 2), pn = tile & 3, koff = (kp < 2) ? kp * 768 : 1536 + (kp - 2) * 640;
        u.A = A + (size_t)pm * 256 * 2816 + koff; u.B = B + (size_t)pn * 256 * 2816 + koff; u.nt = (kp < 2) ? 12 : 10; u.pm = pm; u.pn = pn; u.mode = 1 + kp; return true;
    }
};

#define FOR_AI_M _Pragma("unroll") for (int ai = 0; ai < 2; ++ai) _Pragma("unroll") for (int m = 0; m < 4; ++m)

struct EpiG1 {
    bf16_t *YAB, *YD, *KA, *VA, *KC, *VC, *UC; const float* qkg; const float* tab;
    __device__ __forceinline__ void operator()(const f32x4 (&acc)[2][2][4][2], const Unit& u, int wr, int wc, int fr, int fq) const {
        const int pn = u.pn; const bool isctx = u.pm >= 128;
        int kind; bf16_t* dst = nullptr; int pitch = 0, colbase = 0; const float* gain = qkg;
        if (pn < 2) { kind = 0; dst = YAB; pitch = 1024; colbase = 256 * pn + 64 * wc; gain = qkg; }
        else if (pn == 2) { if (wc < 2) { kind = 1; dst = KA; pitch = 128; colbase = 64 * wc; gain = qkg + 64; } else { kind = 2; dst = VA; pitch = 128; colbase = 64 * (wc - 2); } }
        else if (pn < 5) { kind = 3; }
        else if (pn < 7) { kind = 0; dst = YD; pitch = 1024; colbase = 256 * (pn - 5) + 64 * wc; gain = qkg + 128; }
        else if (pn < 9) { kind = 1; dst = KC; pitch = 512; colbase = 256 * (pn - 7) + 64 * wc; gain = qkg + 192; }
        else { kind = 2; dst = VC; pitch = 512; colbase = 256 * (pn - 9) + 64 * wc; }
        if (kind <= 1) {
            f32x4 g[2][2];
#pragma unroll
            for (int bj = 0; bj < 2; ++bj)
#pragma unroll
                for (int n = 0; n < 2; ++n) g[bj][n] = *(const __attribute__((address_space(1))) f32x4*)(gain + 32 * bj + 8 * fq + 4 * n);
            const float qs = (kind == 0) ? QSCALE : 1.0f;
            FOR_AI_M {
                const int row = 256 * u.pm + 128 * ai + 64 * wr + 16 * m + fr;
                f32x4 x[2][2]; float ss = 0.f;
#pragma unroll
                for (int bj = 0; bj < 2; ++bj)
#pragma unroll
                    for (int n = 0; n < 2; ++n) { x[bj][n] = acc[ai][bj][m][n]; ss += (x[bj][n][0] * x[bj][n][0] + x[bj][n][1] * x[bj][n][1]) + (x[bj][n][2] * x[bj][n][2] + x[bj][n][3] * x[bj][n][3]); }
                ss += shx<16>(ss); ss = sum_x32(ss);
                const float rinv = rsqrtf(ss * (1.0f / 64.0f) + EPS);
#pragma unroll
                for (int bj = 0; bj < 2; ++bj)
#pragma unroll
                    for (int n = 0; n < 2; ++n) x[bj][n] = x[bj][n] * rinv * g[bj][n];
                if (!isctx) {
                    const int t = row & (SEQ - 1); const int p = (fq < 2) ? (t >> 6) : (t & 63);
                    const float* tp = tab + (p * 16 + 8 * (fq & 1)) * 2;
#pragma unroll
                    for (int n = 0; n < 2; ++n) {
                        const f32x4 cs0 = *(const __attribute__((address_space(1))) f32x4*)(tp + 8 * n), cs1 = *(const __attribute__((address_space(1))) f32x4*)(tp + 8 * n + 4);
                        const float c[4] = {cs0[0], cs0[2], cs1[0], cs1[2]}, s[4] = {cs0[1], cs0[3], cs1[1], cs1[3]};
#pragma unroll
                        for (int e = 0; e < 4; ++e) { const float lo = x[0][n][e], hi = x[1][n][e]; x[0][n][e] = lo * c[e] - hi * s[e]; x[1][n][e] = hi * c[e] + lo * s[e]; }
                    }
                }
#pragma unroll
                for (int bj = 0; bj < 2; ++bj) {
                    u32x4 w; w.x = cvt_pk_bf16(x[bj][0][0] * qs, x[bj][0][1] * qs); w.y = cvt_pk_bf16(x[bj][0][2] * qs, x[bj][0][3] * qs);
                    w.z = cvt_pk_bf16(x[bj][1][0] * qs, x[bj][1][1] * qs); w.w = cvt_pk_bf16(x[bj][1][2] * qs, x[bj][1][3] * qs);
                    *(__attribute__((address_space(1))) u32x4*)(dst + (size_t)row * pitch + colbase + 32 * bj + 8 * fq) = w;
                }
            }
        } else if (kind == 2) {
            FOR_AI_M {
                const int row = 256 * u.pm + 128 * ai + 64 * wr + 16 * m + fr;
#pragma unroll
                for (int bj = 0; bj < 2; ++bj) {
                    const f32x4 a = acc[ai][bj][m][0], b = acc[ai][bj][m][1];
                    u32x4 w; w.x = cvt_pk_bf16(a[0], a[1]); w.y = cvt_pk_bf16(a[2], a[3]); w.z = cvt_pk_bf16(b[0], b[1]); w.w = cvt_pk_bf16(b[2], b[3]);
                    *(__attribute__((address_space(1))) u32x4*)(dst + (size_t)row * pitch + colbase + 32 * bj + 8 * fq) = w;
                }
            }
        } else {
            FOR_AI_M {
                const int row = 256 * u.pm + 128 * ai + 64 * wr + 16 * m + fr;
#pragma unroll
                for (int bj = 0; bj < 2; ++bj) {
                    const int g = 16 * (pn - 3) + 4 * wc + 2 * bj + (fq >> 1);
                    const f32x4 a = acc[ai][bj][m][0], b = acc[ai][bj][m][1];
                    u32x4 w; w.x = cvt_pk_bf16(a[0], a[1]); w.y = cvt_pk_bf16(a[2], a[3]); w.z = cvt_pk_bf16(b[0], b[1]); w.w = cvt_pk_bf16(b[2], b[3]);
                    *(__attribute__((address_space(1))) u32x4*)(UC + ((size_t)g * CHPAD + (row >> 5)) * 768 + (row & 31) * 16 + 8 * (fq & 1)) = w;
                }
            }
        }
    }
};

struct EpiS {
    float* S;
    __device__ __forceinline__ void operator()(const f32x4 (&acc)[2][2][4][2], const Unit& u, int wr, int wc, int fr, int fq) const {
        FOR_AI_M {
            const int chunk = 256 * u.pm + 128 * ai + 64 * wr + 16 * m + fr;
            float* rp = S + ((size_t)u.mode * CHPAD + chunk) * 256 + 32 * wc + 4 * fq;
#pragma unroll
            for (int bj = 0; bj < 2; ++bj)
#pragma unroll
                for (int n = 0; n < 2; ++n) *(__attribute__((address_space(1))) f32x4*)(rp + 128 * bj + 16 * n) = acc[ai][bj][m][n];
        }
    }
};

struct EpiY {
    bf16_t* GACT;
    __device__ __forceinline__ void operator()(const f32x4 (&acc)[2][2][4][2], const Unit& u, int wr, int wc, int fr, int fq) const {
        FOR_AI_M {
            const int chunk = 256 * u.pm + 128 * ai + 64 * wr + 16 * m + fr;
            if (chunk < NCHUNK) {
#pragma unroll
                for (int bj = 0; bj < 2; ++bj)
#pragma unroll
                    for (int n = 0; n < 2; ++n) {
                        const int tl = 16 * u.pn + 8 * bj + 2 * wc + n; const size_t row = (size_t)chunk * 32 + tl;
                        const f32x4 v = acc[ai][bj][m][n];
                        u32x2 w; w.x = cvt_pk_bf16(gelu_tanh(v[0]), gelu_tanh(v[1])); w.y = cvt_pk_bf16(gelu_tanh(v[2]), gelu_tanh(v[3]));
                        *(__attribute__((address_space(1))) u32x2*)(GACT + row * 1024 + 16 * u.mode + 4 * fq) = w;
                    }
            }
        }
    }
};

struct EpiGLU {
    const bf16_t* GACT; bf16_t* YB; const float* bglu;
    __device__ __forceinline__ void operator()(const f32x4 (&acc)[2][2][4][2], const Unit& u, int wr, int wc, int fr, int fq) const {
        f32x4 bv[2][2];
#pragma unroll
        for (int bj = 0; bj < 2; ++bj)
#pragma unroll
            for (int n = 0; n < 2; ++n) bv[bj][n] = *(const __attribute__((address_space(1))) f32x4*)(bglu + 256 * u.pn + 128 * bj + 32 * wc + 8 * fq + 4 * n);
        const size_t col0 = (size_t)256 * u.pn + 32 * wc + 8 * fq;
        u32x4 gpre[2][2];
#pragma unroll
        for (int bj = 0; bj < 2; ++bj) gpre[0][bj] = *(const __attribute__((address_space(1))) u32x4*)(GACT + ((size_t)256 * u.pm + 64 * wr + fr) * 1024 + col0 + 128 * bj);
#pragma unroll
        for (int g = 0; g < 8; ++g) {
            const int ai = g >> 2, m = g & 3;
            const size_t row = (size_t)256 * u.pm + 128 * ai + 64 * wr + 16 * m + fr;
            if (g + 1 < 8) {
                const size_t rn = (size_t)256 * u.pm + 128 * ((g + 1) >> 2) + 64 * wr + 16 * ((g + 1) & 3) + fr;
#pragma unroll
                for (int bj = 0; bj < 2; ++bj) gpre[(g + 1) & 1][bj] = *(const __attribute__((address_space(1))) u32x4*)(GACT + rn * 1024 + col0 + 128 * bj);
            }
            asm volatile("" ::: "memory");
#pragma unroll
            for (int bj = 0; bj < 2; ++bj) {
                const u32x4 gv = gpre[g & 1][bj];
                const f32x4 a = acc[ai][bj][m][0] + bv[bj][0], b = acc[ai][bj][m][1] + bv[bj][1];
                u32x4 w;
                w.x = cvt_pk_bf16(bflo(gv.x) * sigmoidf_(a[0]), bfhi(gv.x) * sigmoidf_(a[1])); w.y = cvt_pk_bf16(bflo(gv.y) * sigmoidf_(a[2]), bfhi(gv.y) * sigmoidf_(a[3]));
                w.z = cvt_pk_bf16(bflo(gv.z) * sigmoidf_(b[0]), bfhi(gv.z) * sigmoidf_(b[1])); w.w = cvt_pk_bf16(bflo(gv.w) * sigmoidf_(b[2]), bfhi(gv.w) * sigmoidf_(b[3]));
                *(__attribute__((address_space(1))) u32x4*)(YB + row * 1024 + col0 + 128 * bj) = w;
            }
        }
    }
};

struct EpiMerge {
    bf16_t* M; float* stm; unsigned* stg; int tid_; bf16_t* MCTX;
    __device__ __forceinline__ void operator()(const f32x4 (&acc)[2][2][4][2], const Unit& u, int wr, int wc, int fr, int fq) const {
        const int sub = u.mode, tid = (wr * 4 + wc) * 64 + fq * 16 + fr;
        if ((sub & 1) == 0) {
            FOR_AI_M {
#pragma unroll
                for (int bj = 0; bj < 2; ++bj) {
                    const int i0 = (((ai * 2 + bj) * 4 + m) * 2) * 512 + tid, i1 = i0 + 512;
                    const f32x4 a = acc[ai][bj][m][0], b = acc[ai][bj][m][1];
                    u32x2 w0, w1; w0.x = cvt_pk_bf16(sigmoidf_(a[0]), sigmoidf_(a[1])); w0.y = cvt_pk_bf16(sigmoidf_(a[2]), sigmoidf_(a[3]));
                    w1.x = cvt_pk_bf16(sigmoidf_(b[0]), sigmoidf_(b[1])); w1.y = cvt_pk_bf16(sigmoidf_(b[2]), sigmoidf_(b[3]));
                    *(__attribute__((address_space(1))) u32x2*)(stg + (size_t)i0 * 2) = w0; *(__attribute__((address_space(1))) u32x2*)(stg + (size_t)i1 * 2) = w1;
                }
                asm volatile("" ::: "memory");
            }
            return;
        }
        const bool iso = sub >= 8, addm = (sub > 1) && !iso;
        u32x2 gp[2][2][2]; f32x4 mp[2][2][2];
#pragma unroll
        for (int bj = 0; bj < 2; ++bj) {
            const int i0 = ((bj * 4) * 2) * 512 + tid, i1 = i0 + 512;
            gp[0][bj][0] = *(const __attribute__((address_space(1))) u32x2*)(stg + (size_t)i0 * 2); gp[0][bj][1] = *(const __attribute__((address_space(1))) u32x2*)(stg + (size_t)i1 * 2);
            if (addm) { mp[0][bj][0] = *(const __attribute__((address_space(1))) f32x4*)(stm + (size_t)i0 * 4); mp[0][bj][1] = *(const __attribute__((address_space(1))) f32x4*)(stm + (size_t)i1 * 4); }
        }
#pragma unroll
        for (int g = 0; g < 8; ++g) {
            const int ai = g >> 2, m = g & 3;
            const size_t row = (size_t)256 * u.pm + 128 * ai + 64 * wr + 16 * m + fr;
            if (g + 1 < 8) {
                const int an = (g + 1) >> 2, mn = (g + 1) & 3;
#pragma unroll
                for (int bj = 0; bj < 2; ++bj) {
                    const int i0 = (((an * 2 + bj) * 4 + mn) * 2) * 512 + tid, i1 = i0 + 512;
                    gp[(g + 1) & 1][bj][0] = *(const __attribute__((address_space(1))) u32x2*)(stg + (size_t)i0 * 2); gp[(g + 1) & 1][bj][1] = *(const __attribute__((address_space(1))) u32x2*)(stg + (size_t)i1 * 2);
                    if (addm) { mp[(g + 1) & 1][bj][0] = *(const __attribute__((address_space(1))) f32x4*)(stm + (size_t)i0 * 4); mp[(g + 1) & 1][bj][1] = *(const __attribute__((address_space(1))) f32x4*)(stm + (size_t)i1 * 4); }
                }
            }
            asm volatile("" ::: "memory");
#pragma unroll
            for (int bj = 0; bj < 2; ++bj) {
                const int i0 = (((ai * 2 + bj) * 4 + m) * 2) * 512 + tid, i1 = i0 + 512;
                const u32x2 g0 = gp[g & 1][bj][0], g1 = gp[g & 1][bj][1];
                f32x4 a = acc[ai][bj][m][0], b = acc[ai][bj][m][1];
                a = a * (f32x4){bflo(g0.x), bfhi(g0.x), bflo(g0.y), bfhi(g0.y)}; b = b * (f32x4){bflo(g1.x), bfhi(g1.x), bflo(g1.y), bfhi(g1.y)};
                if (addm) { a += mp[g & 1][bj][0]; b += mp[g & 1][bj][1]; }
                if (sub < 5) { *(__attribute__((address_space(1))) f32x4*)(stm + (size_t)i0 * 4) = a; *(__attribute__((address_space(1))) f32x4*)(stm + (size_t)i1 * 4) = b; }
                else {
                    u32x4 w; w.x = cvt_pk_bf16(a[0], a[1]); w.y = cvt_pk_bf16(a[2], a[3]); w.z = cvt_pk_bf16(b[0], b[1]); w.w = cvt_pk_bf16(b[2], b[3]);
                    bf16_t* dst = iso ? MCTX + (size_t)((sub - 8) >> 1) * NCTX * 1024 + (row - NLAT) * 1024 : M + row * 1024;
                    *(__attribute__((address_space(1))) u32x4*)(dst + 256 * u.pn + 128 * bj + 32 * wc + 8 * fq) = w;
                }
            }
        }
    }
};

struct EpiRes {
    const float* base_lat; const float* base_ctx; float* out_lat; float* out_ctx; const float* mod; int moff; float* part;
    __device__ __forceinline__ void operator()(const f32x4 (&acc)[2][2][4][2], const Unit& u, int wr, int wc, int fr, int fq) const {
        const int row0 = 256 * u.pm; const bool isctx = row0 >= NLAT; const int mb = isctx ? 4 : (row0 >> 13);
        const float* bp = isctx ? base_ctx + (size_t)(row0 - NLAT) * 1024 : base_lat + (size_t)row0 * 1024;
        float* op = isctx ? out_ctx + (size_t)(row0 - NLAT) * 1024 : out_lat + (size_t)row0 * 1024;
        const float* mp = mod + mb * 6144 + moff;
        f32x4 mv[2][2];
#pragma unroll
        for (int bj = 0; bj < 2; ++bj)
#pragma unroll
            for (int n = 0; n < 2; ++n) mv[bj][n] = *(const __attribute__((address_space(1))) f32x4*)(mp + 256 * u.pn + 128 * bj + 32 * wc + 8 * fq + 4 * n);
        const size_t cb0 = (size_t)256 * u.pn + 32 * wc + 8 * fq;
        if (u.mode > 0) {
            float* pp = part + (size_t)(u.mode - 1) * NCTX * 1024 + (size_t)(row0 - NLAT) * 1024;
            FOR_AI_M {
                const size_t ro = (size_t)(128 * ai + 64 * wr + 16 * m + fr) * 1024 + cb0;
#pragma unroll
                for (int bj = 0; bj < 2; ++bj)
#pragma unroll
                    for (int n = 0; n < 2; ++n) *(__attribute__((address_space(1))) f32x4*)(pp + ro + 128 * bj + 4 * n) = mv[bj][n] * acc[ai][bj][m][n];
            }
            return;
        }
        f32x4 pre[2][2][2];
#pragma unroll
        for (int bj = 0; bj < 2; ++bj)
#pragma unroll
            for (int n = 0; n < 2; ++n) pre[0][bj][n] = *(const __attribute__((address_space(1))) f32x4*)(bp + (size_t)(64 * wr + fr) * 1024 + cb0 + 128 * bj + 4 * n);
#pragma unroll
        for (int g = 0; g < 8; ++g) {
            const int ai = g >> 2, m = g & 3;
            const size_t ro = (size_t)(128 * ai + 64 * wr + 16 * m + fr) * 1024 + cb0;
            if (g + 1 < 8) {
                const size_t rn = (size_t)(128 * ((g + 1) >> 2) + 64 * wr + 16 * ((g + 1) & 3) + fr) * 1024 + cb0;
#pragma unroll
                for (int bj = 0; bj < 2; ++bj)
#pragma unroll
                    for (int n = 0; n < 2; ++n) pre[(g + 1) & 1][bj][n] = *(const __attribute__((address_space(1))) f32x4*)(bp + rn + 128 * bj + 4 * n);
            }
            asm volatile("" ::: "memory");
#pragma unroll
            for (int bj = 0; bj < 2; ++bj)
#pragma unroll
                for (int n = 0; n < 2; ++n) *(__attribute__((address_space(1))) f32x4*)(op + ro + 128 * bj + 4 * n) = pre[g & 1][bj][n] + mv[bj][n] * acc[ai][bj][m][n];
        }
    }
};

__device__ __forceinline__ float dpp_shr1(float v) { return __builtin_bit_cast(float, __builtin_amdgcn_update_dpp(0, __builtin_bit_cast(int, v), 0x111, 0xf, 0xf, true)); }
__device__ __forceinline__ float dpp_shl1(float v) { return __builtin_bit_cast(float, __builtin_amdgcn_update_dpp(0, __builtin_bit_cast(int, v), 0x101, 0xf, 0xf, true)); }

struct SchedUp {
    const bf16_t* H; const bf16_t* HB; const bf16_t* B; int nM, G, c;
    __device__ __forceinline__ bool next(int i, Unit& u) const {
        const int L = i * G + c, nmain = nM * 22;
        if (L < nmain) { int pm, pn; pg8::tile_of(L, nM, 22, pm, pn); u.A = H + (size_t)pm * 256 * 1024; u.B = B + (size_t)pn * 256 * 1024; u.nt = 16; u.pm = pm; u.pn = pn; u.mode = 0; return true; }
        const int Lb = L - nmain; if (Lb >= 110) return false;
        const int mt = Lb / 22, pn = Lb - mt * 22;
        u.A = HB + (size_t)mt * 256 * 1024; u.B = B + (size_t)pn * 256 * 1024; u.nt = 16; u.pm = mt; u.pn = pn; u.mode = 1; return true;
    }
};

struct EpiUpConv {
    bf16_t* ACT; int nrows; const float* cw; const float* cb;
    __device__ __forceinline__ void operator()(const f32x4 (&acc)[2][2][4][2], const Unit& u, int wr, int wc, int fr, int fq) const {
        if (u.mode == 1) {
#pragma unroll
            for (int n = 0; n < 2; ++n) {
                const int f0 = 128 * u.pn + 32 * wc + 8 * fq + 4 * n;
                f32x4 wa[3], wg[3];
#pragma unroll
                for (int j = 0; j < 3; ++j) { wa[j] = *(const __attribute__((address_space(1))) f32x4*)(cw + j * 5632 + f0); wg[j] = *(const __attribute__((address_space(1))) f32x4*)(cw + j * 5632 + 2816 + f0); }
                const f32x4 ba = *(const __attribute__((address_space(1))) f32x4*)(cb + f0), bg = *(const __attribute__((address_space(1))) f32x4*)(cb + 2816 + f0);
#pragma unroll
                for (int ai = 0; ai < 2; ++ai) {
                    const int j = 64 * u.pm + 32 * wr + 2 * fr + ai;
                    const bool seqb = (j < 256) ? ((j & 63) == 0) : ((j & 1) == 0);
                    const f32x4 z4 = (f32x4){0.f, 0.f, 0.f, 0.f};
                    const int rowL = 128 * j - 1, rowR = 128 * j;
                    if (j >= 1 && j < NBGRP && rowL < nrows) {
                        const f32x4 ca = wa[0] * acc[ai][0][0][n] + wa[1] * acc[ai][0][1][n] + wa[2] * (seqb ? z4 : acc[ai][0][2][n]) + ba;
                        const f32x4 cg = wg[0] * acc[ai][1][0][n] + wg[1] * acc[ai][1][1][n] + wg[2] * (seqb ? z4 : acc[ai][1][2][n]) + bg;
                        u32x2 w; w.x = cvt_pk_bf16(cg[0] * sigmoidf_(cg[0]) * ca[0], cg[1] * sigmoidf_(cg[1]) * ca[1]); w.y = cvt_pk_bf16(cg[2] * sigmoidf_(cg[2]) * ca[2], cg[3] * sigmoidf_(cg[3]) * ca[3]);
                        *(__attribute__((address_space(1))) u32x2*)(ACT + (size_t)rowL * 2816 + f0) = w;
                    }
                    if (j < NBGRP && rowR < nrows) {
                        const f32x4 ca = wa[0] * (seqb ? z4 : acc[ai][0][1][n]) + wa[1] * acc[ai][0][2][n] + wa[2] * acc[ai][0][3][n] + ba;
                        const f32x4 cg = wg[0] * (seqb ? z4 : acc[ai][1][1][n]) + wg[1] * acc[ai][1][2][n] + wg[2] * acc[ai][1][3][n] + bg;
                        u32x2 w; w.x = cvt_pk_bf16(cg[0] * sigmoidf_(cg[0]) * ca[0], cg[1] * sigmoidf_(cg[1]) * ca[1]); w.y = cvt_pk_bf16(cg[2] * sigmoidf_(cg[2]) * ca[2], cg[3] * sigmoidf_(cg[3]) * ca[3]);
                        *(__attribute__((address_space(1))) u32x2*)(ACT + (size_t)rowR * 2816 + f0) = w;
                    }
                }
            }
            return;
        }
        const size_t row0 = (size_t)256 * u.pm + 128 * wr + 8 * fr;
#pragma unroll
        for (int n = 0; n < 2; ++n) {
            const int f0 = 128 * u.pn + 32 * wc + 8 * fq + 4 * n;
            f32x4 wa[3], wg[3];
#pragma unroll
            for (int j = 0; j < 3; ++j) { wa[j] = *(const __attribute__((address_space(1))) f32x4*)(cw + j * 5632 + f0); wg[j] = *(const __attribute__((address_space(1))) f32x4*)(cw + j * 5632 + 2816 + f0); }
            const f32x4 ba = *(const __attribute__((address_space(1))) f32x4*)(cb + f0), bg = *(const __attribute__((address_space(1))) f32x4*)(cb + 2816 + f0);
            f32x4 pa, pg, na, ng;
#pragma unroll
            for (int e = 0; e < 4; ++e) { pa[e] = dpp_shr1(acc[1][0][3][n][e]); pg[e] = dpp_shr1(acc[1][1][3][n][e]); na[e] = dpp_shl1(acc[0][0][0][n][e]); ng[e] = dpp_shl1(acc[0][1][0][n][e]); }
#pragma unroll
            for (int k = 0; k < 8; ++k) {
                const f32x4 ua0 = (k == 0) ? pa : acc[(k - 1) >> 2][0][(k - 1) & 3][n], ua1 = acc[k >> 2][0][k & 3][n], ua2 = (k == 7) ? na : acc[(k + 1) >> 2][0][(k + 1) & 3][n];
                const f32x4 ug0 = (k == 0) ? pg : acc[(k - 1) >> 2][1][(k - 1) & 3][n], ug1 = acc[k >> 2][1][k & 3][n], ug2 = (k == 7) ? ng : acc[(k + 1) >> 2][1][(k + 1) & 3][n];
                const f32x4 ca = wa[0] * ua0 + wa[1] * ua1 + wa[2] * ua2 + ba, cg = wg[0] * ug0 + wg[1] * ug1 + wg[2] * ug2 + bg;
                u32x2 w; w.x = cvt_pk_bf16(cg[0] * sigmoidf_(cg[0]) * ca[0], cg[1] * sigmoidf_(cg[1]) * ca[1]); w.y = cvt_pk_bf16(cg[2] * sigmoidf_(cg[2]) * ca[2], cg[3] * sigmoidf_(cg[3]) * ca[3]);
                const bool edge = (k == 0 && fr == 0) || (k == 7 && fr == 15);
                if (!edge) *(__attribute__((address_space(1))) u32x2*)(ACT + (row0 + k) * 2816 + f0) = w;
            }
        }
    }
};

#define XB_TMO      128
#define XB_XCNT(j)  (256  + 64 * (j))
#define XB_XSUB(j)  (1280 + 64 * (j))
#define XB_XGEN(j)  (2304 + 64 * (j))
#define XB_TOP      3328
#define XB_TOPGEN   3392
#define XCD_BAR_WORDS 3456
#define XB_SPIN_CAP (1u << 22)
__device__ __forceinline__ unsigned xb_ld(unsigned* p)              { return __hip_atomic_load(p, __ATOMIC_RELAXED, __HIP_MEMORY_SCOPE_AGENT); }
__device__ __forceinline__ unsigned xb_add(unsigned* p, unsigned v) { return __hip_atomic_fetch_add(p, v, __ATOMIC_RELAXED, __HIP_MEMORY_SCOPE_AGENT); }
__device__ __forceinline__ unsigned xb_xcc_id() { return (unsigned)__builtin_amdgcn_s_getreg((3 << 11) | 20) & 0xFu; }
#define XB_SPIN(cond, bar) do { unsigned _sp = 0; while (cond) { __builtin_amdgcn_s_sleep(1); \
    if ((++_sp & 255u) == 0u) { if (xb_ld(&(bar)[XB_TMO])) break; if (_sp > XB_SPIN_CAP) { atomicAdd(&(bar)[XB_TMO], 1u); break; } } } } while (0)
struct XcdBarrier { unsigned* bar; unsigned x; volatile LAS unsigned* st; };
__device__ __forceinline__ XcdBarrier xcd_barrier_post(unsigned* bar, volatile LAS unsigned* st) {
    XcdBarrier b; b.bar = bar; b.x = xb_xcc_id(); b.st = st;
    if (threadIdx.x == 0) (void)xb_add(&bar[XB_XCNT(b.x)], 1u);
    return b;
}
__device__ __forceinline__ void xcd_barrier_complete(unsigned* bar, unsigned x, unsigned& nloc, unsigned& nx) {
    const unsigned G = gridDim.x * gridDim.y * gridDim.z;
    unsigned sum, cnt, mine, sp = 0u;
    for (;;) {
        sum = 0u; cnt = 0u; mine = 0u;
#pragma unroll
        for (unsigned j = 0; j < 16; ++j) { const unsigned c = xb_ld(&bar[XB_XCNT(j)]); sum += c; cnt += (c > 0u) ? 1u : 0u; mine = (j == x) ? c : mine; }
        if (sum == G) break;
        __builtin_amdgcn_s_sleep(1);
        if ((++sp & 255u) == 0u) { if (xb_ld(&bar[XB_TMO])) break; if (sp > XB_SPIN_CAP) { atomicAdd(&bar[XB_TMO], 1u); break; } }
    }
    nloc = mine > 0u ? mine : 1u; nx = cnt > 0u ? cnt : 1u;
}
__device__ __forceinline__ void xcd_barrier(const XcdBarrier& b) {
    asm volatile("s_waitcnt vmcnt(0)" ::: "memory");
    __syncthreads();
    if (threadIdx.x == 0) {
        unsigned* bar = b.bar;
        __builtin_amdgcn_s_waitcnt(0);
        unsigned nloc = b.st[0], nx = b.st[1];
        if (nloc == 0u) { xcd_barrier_complete(bar, b.x, nloc, nx); b.st[0] = nloc; b.st[1] = nx; }
        const unsigned old = xb_add(&bar[XB_XSUB(b.x)], 1u);
        const unsigned gen = old / nloc;
        if (old + 1u == (gen + 1u) * nloc) {
            __builtin_amdgcn_fence(__ATOMIC_RELEASE, "agent");
            asm volatile("s_waitcnt vmcnt(0)" ::: "memory");
            const unsigned og = xb_add(&bar[XB_TOP], 1u);
            const unsigned tg = og / nx;
            if (og + 1u == (tg + 1u) * nx) xb_add(&bar[XB_TOPGEN], 1u);
            else XB_SPIN(xb_ld(&bar[XB_TOPGEN]) == tg, bar);
            __builtin_amdgcn_fence(__ATOMIC_ACQUIRE, "agent");
            xb_add(&bar[XB_XGEN(b.x)], 1u);
            asm volatile("s_waitcnt vmcnt(0)" ::: "memory");
        } else {
            XB_SPIN(xb_ld(&bar[XB_XGEN(b.x)]) == gen, bar);
            __builtin_amdgcn_fence(__ATOMIC_ACQUIRE, "agent");
            asm volatile("s_waitcnt vmcnt(0)" ::: "memory");
        }
    }
    __syncthreads();
}

struct Frame {
    unsigned char* lds; int tid, lane, wave, G, bid;
};

__device__ __forceinline__ void transpose_item(const float* W, int ldw, int k0, int n0, bf16_t* WT, int ldt, int drow0, int kdst0, float* scr, int lane) {
#pragma unroll 8
    for (int i = 0; i < 32; ++i) { const int kk = 2 * i + (lane >> 5); scr[kk * 33 + (lane & 31)] = W[(size_t)(k0 + kk) * ldw + n0 + (lane & 31)]; }
    asm volatile("s_waitcnt lgkmcnt(0)" ::: "memory");
    const int c = lane & 7;
#pragma unroll
    for (int j = 0; j < 4; ++j) {
        const int n = (lane >> 3) + 8 * j; const float* s = scr + (8 * c) * 33 + n;
        u32x4 o; o.x = cvt_pk_bf16(s[0 * 33], s[1 * 33]); o.y = cvt_pk_bf16(s[2 * 33], s[3 * 33]); o.z = cvt_pk_bf16(s[4 * 33], s[5 * 33]); o.w = cvt_pk_bf16(s[6 * 33], s[7 * 33]);
        const int di = 16 * ((n >> 2) & 1) + 4 * (n >> 3) + (n & 3);
        *(u32x4*)(WT + (size_t)(drow0 + di) * ldt + kdst0 + k0 + 8 * c) = o;
    }
    asm volatile("s_waitcnt lgkmcnt(0)" ::: "memory");
}

__device__ __forceinline__ void prep_weights(const Frame& F, const Params& P, int l) {
    float* scr = (float*)(F.lds + F.wave * 16384);
    bf16_t* Wb = (bf16_t*)(P.ws + WS_W);
    const float* w_in = P.in[7] + (size_t)l * 1024 * NIN; const float* w_glu = P.in[17] + (size_t)l * 512 * 512; const float* w_br = P.in[21] + (size_t)l * 3 * 512 * 1024;
    const float* w_out = P.in[22] + (size_t)l * 1024 * 1024; const float* w_up = P.in[23] + (size_t)l * 1024 * 5632; const float* w_down = P.in[26] + (size_t)l * 2816 * 1024;
    constexpr int I1 = 16 * 88, I2 = 3 * 16 * 32, I3 = 3 * 8 * 32, I4 = 8 * 16, I5 = 16 * 32, I6 = 16 * 176, I7 = 44 * 32;
    constexpr int NIT = I1 + I2 + I3 + I4 + I5 + I6 + I7;
    const int gw = F.bid * 8 + F.wave, NGW = F.G * 8;
    for (int it = gw; it < NIT; it += NGW) {
        int r = it;
        if (r < I1) { const int kb = r / 88, dg = r % 88, pn = dg >> 3, bj = (dg >> 2) & 1, wc = dg & 3;
            transpose_item(w_in, NIN, 64 * kb, 256 * pn + 64 * wc + 32 * bj, (bf16_t*)((unsigned char*)Wb + W_WIN), 1024, 32 * dg, 0, scr, F.lane); continue; } r -= I1;
        if (r < I2) { const int j = r / 512, rr = r % 512, kb = rr / 32, dg = rr % 32;
            transpose_item(w_in, NIN, 64 * kb, 2816 + 1024 * j + 32 * dg, (bf16_t*)((unsigned char*)Wb + W_BCAT) + (size_t)j * 1024 * 1536, 1536, 32 * dg, 0, scr, F.lane); continue; } r -= I2;
        if (r < I3) { const int j = r / 256, rr = r % 256, kb = rr / 32, dg = rr % 32;
            transpose_item(w_br + (size_t)j * 512 * 1024, 1024, 64 * kb, 32 * dg, (bf16_t*)((unsigned char*)Wb + W_BCAT) + (size_t)j * 1024 * 1536, 1536, 32 * dg, 1024, scr, F.lane); continue; } r -= I3;
        if (r < I4) { const int kb = r / 16, dg = r % 16;
            transpose_item(w_glu, 512, 64 * kb, 32 * dg, (bf16_t*)((unsigned char*)Wb + W_GLU), 512, 32 * dg, 0, scr, F.lane); continue; } r -= I4;
        if (r < I5) { const int kb = r / 32, dg = r % 32;
            transpose_item(w_out, 1024, 64 * kb, 32 * dg, (bf16_t*)((unsigned char*)Wb + W_OUT), 1024, 32 * dg, 0, scr, F.lane); continue; } r -= I5;
        if (r < I6) { const int kb = r / 176, dg = r % 176, pn = dg >> 3, bj = (dg >> 2) & 1, wc = dg & 3;
            transpose_item(w_up, 5632, 64 * kb, bj * 2816 + 128 * pn + 32 * wc, (bf16_t*)((unsigned char*)Wb + W_UP), 1024, 32 * dg, 0, scr, F.lane); continue; } r -= I6;
        { const int kb = r / 32, dg = r % 32;
            transpose_item(w_down, 1024, 64 * kb, 32 * dg, (bf16_t*)((unsigned char*)Wb + W_DOWN), 2816, 32 * dg, 0, scr, F.lane); }
    }
}

__device__ __forceinline__ void prep_s5_part(const Frame& F, const Params& P, int l, int g, int c) {
    float* apr = (float*)F.lds;
    float* api = apr + 2 * 33 * 64;
    float* bbr = api + 2 * 33 * 64;
    float* bbi = bbr + 2 * 64 * 16;
    float* ccr = bbi + 2 * 64 * 16;
    float* cci = ccr + 2 * 64;
    float* Kt = cci + 2 * 64;
    const float* lam_re = P.in[9]; const float* lam_im = P.in[10]; const float* log_dt = P.in[11];
    const float* b_re = P.in[12]; const float* b_im = P.in[13]; const float* c_re = P.in[14]; const float* c_im = P.in[15]; const float* dsk = P.in[16] + l * 512 + g * 16;
    __syncthreads();
    for (int idx = F.tid; idx < 2 * 33 * 64; idx += 512) {
        const int d = idx / (33 * 64), e = (idx / 64) % 33, p = idx % 64; const int gi = (l * 2 + d) * 32 + g;
        const float lr = lam_re[gi * 64 + p], li = lam_im[gi * 64 + p], dt = expf(log_dt[gi]);
        const float mag = expf((float)e * lr * dt), ang = (float)e * li * dt; float sn, cs; sincosf(ang, &sn, &cs);
        apr[idx] = mag * cs; api[idx] = mag * sn;
    }
    if (F.tid < 128) { const int d = F.tid >> 6, p = F.tid & 63; const size_t gi = (size_t)((l * 2 + d) * 32 + g);
        ccr[F.tid] = c_re[(gi * 16 + c) * 64 + p]; cci[F.tid] = c_im[(gi * 16 + c) * 64 + p]; }
    __syncthreads();
    for (int idx = F.tid; idx < 2 * 64 * 16; idx += 512) {
        const int d = idx >> 10, p = (idx >> 4) & 63, c2 = idx & 15; const size_t gi = (size_t)((l * 2 + d) * 32 + g);
        const float lr = lam_re[gi * 64 + p], li = lam_im[gi * 64 + p];
        const float ar = apr[(d * 33 + 1) * 64 + p], ai = api[(d * 33 + 1) * 64 + p], den = lr * lr + li * li;
        const float fr_ = ((ar - 1.0f) * lr + ai * li) / den, fi_ = (ai * lr - (ar - 1.0f) * li) / den;
        const float br = b_re[(gi * 64 + p) * 16 + c2], bi = b_im[(gi * 64 + p) * 16 + c2];
        bbr[idx] = fr_ * br - fi_ * bi; bbi[idx] = fr_ * bi + fi_ * br;
    }
    __syncthreads();
    for (int idx = F.tid; idx < 2 * 32 * 16; idx += 512) {
        const int d = idx >> 9, tau = (idx >> 4) & 31, c2 = idx & 15;
        const float* a_r = apr + (d * 33 + tau) * 64; const float* a_i = api + (d * 33 + tau) * 64;
        const float* c_r = ccr + d * 64; const float* c_i = cci + d * 64;
        const float* b_r = bbr + d * 1024 + c2; const float* b_i = bbi + d * 1024 + c2;
        float sacc = 0.f;
#pragma unroll 4
        for (int p = 0; p < 64; ++p) { const float wr_ = c_r[p] * a_r[p] - c_i[p] * a_i[p], wi_ = c_r[p] * a_i[p] + c_i[p] * a_r[p]; sacc += wr_ * b_r[p * 16] - wi_ * b_i[p * 16]; }
        Kt[idx] = sacc;
    }
    __syncthreads();
    bf16_t* M1 = (bf16_t*)(P.ws + WS_W + W_M1) + (size_t)g * 256 * 512;
    bf16_t* TM2 = (bf16_t*)(P.ws + WS_W + W_TM2) + (size_t)g * 512 * 768;
    for (int v = F.tid; v < 16 * 64; v += 512) {
        const int row = 16 * c + (v >> 6), cv = v & 63, s_ = cv >> 1, c0 = 8 * (cv & 1), d = row >> 7, ri = (row >> 6) & 1, p = row & 63;
        const int e = (d == 0) ? (31 - s_) : s_; const float ar = apr[(d * 33 + e) * 64 + p], ai = api[(d * 33 + e) * 64 + p];
        float o[8];
#pragma unroll
        for (int i = 0; i < 8; ++i) { const float br = bbr[d * 1024 + p * 16 + c0 + i], bi = bbi[d * 1024 + p * 16 + c0 + i]; o[i] = (ri == 0) ? (ar * br - ai * bi) : (ar * bi + ai * br); }
        u32x4 w; w.x = cvt_pk_bf16(o[0], o[1]); w.y = cvt_pk_bf16(o[2], o[3]); w.z = cvt_pk_bf16(o[4], o[5]); w.w = cvt_pk_bf16(o[6], o[7]);
        *(u32x4*)(M1 + (size_t)row * 512 + cv * 8) = w;
    }
    for (int v = F.tid; v < 32 * 96; v += 512) {
        const int t = v / 96, cv = v % 96, row = t * 16 + c;
        float o[8];
        if (cv < 64) {
            const int s_ = cv >> 1, c0 = 8 * (cv & 1);
#pragma unroll
            for (int i = 0; i < 8; ++i) {
                float val = 0.f;
                if (t >= s_) val += Kt[(0 * 32 + (t - s_)) * 16 + c0 + i];
                if (s_ >= t) val += Kt[(1 * 32 + (s_ - t)) * 16 + c0 + i];
                if (t == s_ && c == c0 + i) val += dsk[c];
                o[i] = val;
            }
        } else {
            const int kk = (cv - 64) * 8, d = kk >> 7, ri = (kk >> 6) & 1, p0 = kk & 63, e = (d == 0) ? (t + 1) : (32 - t);
#pragma unroll
            for (int i = 0; i < 8; ++i) {
                const int p = p0 + i; const float cr = ccr[d * 64 + p], ci = cci[d * 64 + p], ar = apr[(d * 33 + e) * 64 + p], ai = api[(d * 33 + e) * 64 + p];
                o[i] = (ri == 0) ? (cr * ar - ci * ai) : -(cr * ai + ci * ar);
            }
        }
        u32x4 w; w.x = cvt_pk_bf16(o[0], o[1]); w.y = cvt_pk_bf16(o[2], o[3]); w.z = cvt_pk_bf16(o[4], o[5]); w.w = cvt_pk_bf16(o[6], o[7]);
        *(u32x4*)(TM2 + (size_t)row * 768 + cv * 8) = w;
    }
    __syncthreads();
}

__device__ __forceinline__ void prep_layer(const Frame& F, const Params& P, int l) {
    for (int it = F.bid; it < 512; it += F.G) prep_s5_part(F, P, l, it >> 4, it & 15);
    __syncthreads();
    prep_weights(F, P, l);
}

__device__ __forceinline__ void phase_adaln(const Frame& F, const Params& P) {
    float* MOD = (float*)(P.ws + WS_MOD); float* TAB = (float*)(P.ws + WS_TAB);
    const float* cvec = P.in[1]; const float* cctx = P.in[3]; const float* w_ada = P.in[4]; const float* b_ada = P.in[5];
    float* sl = (float*)F.lds;
    for (int i = F.tid; i < 5 * 1024; i += 512) { const float cv = (i < 4096) ? cvec[i] : cctx[i - 4096]; sl[i] = cv / (1.0f + __expf(-cv)); }
    __syncthreads();
    for (int it = F.bid; it < 768; it += F.G) {
        const int l = it / 384, r = it % 384, cb = r / 16, ks = r % 16;
        const int col = cb * 256 + (F.tid & 255), kh = F.tid >> 8, kbeg = ks * 64 + kh * 32;
        float a[5] = {0.f, 0.f, 0.f, 0.f, 0.f};
#pragma unroll 8
        for (int k = kbeg; k < kbeg + 32; ++k) {
            const float w = w_ada[((size_t)l * 1024 + k) * 6144 + col];
#pragma unroll
            for (int mb = 0; mb < 5; ++mb) a[mb] += sl[mb * 1024 + k] * w;
        }
        const float bias = (ks == 0 && kh == 0) ? b_ada[l * 6144 + col] : 0.f;
#pragma unroll
        for (int mb = 0; mb < 5; ++mb) atomicAdd(&MOD[(l * 5 + mb) * 6144 + col], a[mb] + bias);
    }
    const int gt = F.bid * 512 + F.tid;
    if (gt < 2048) {
        const int p = gt >> 4, i = gt & 15;
        const float invf = exp2f(-(float)i * (13.287712379549449f / 16.0f)); const float ang = (float)p * invf;
        float sn, cs; sincosf(ang, &sn, &cs);
        TAB[gt * 2] = cs; TAB[gt * 2 + 1] = sn;
    }
}

__device__ __forceinline__ void phase_norm(const Frame& F, const Params& P, int l, int which, int nrows, bf16_t* HB) {
    const float* xl = (l == 0 && which == 0) ? P.in[0] : P.out; const float* xc = (l == 0 && which == 0) ? P.in[2] : (const float*)(P.ws + WS_XC);
    const float* gn = P.in[6] + (l * 2 + which) * 1024; const float* MOD = (const float*)(P.ws + WS_MOD) + l * 5 * 6144;
    bf16_t* H = (bf16_t*)(P.ws + WS_H);
    const int gw = F.bid * 8 + F.wave, NGW = F.G * 8;
    for (int row = gw; row < nrows; row += NGW) {
        const float* xr = (row < NLAT) ? xl + (size_t)row * 1024 : xc + (size_t)(row - NLAT) * 1024;
        const int mb = (row < NLAT) ? (row >> 13) : 4;
        const float* sh = MOD + mb * 6144 + (which ? 3072 : 0); const float* sc = sh + 1024;
        f32x4 v[4]; float ss = 0.f;
#pragma unroll
        for (int j = 0; j < 4; ++j) v[j] = *(const __attribute__((address_space(1))) f32x4*)(xr + 4 * F.lane + 256 * j);
        if (l == 0 && which == 1 && row >= NLAT) {
            const float* cin = P.in[2] + (size_t)(row - NLAT) * 1024 + 4 * F.lane;
            const float* pp = (const float*)(P.ws + WS_AR + AR_PG4) + (size_t)(row - NLAT) * 1024 + 4 * F.lane;
            float* xo = (float*)(P.ws + WS_XC) + (size_t)(row - NLAT) * 1024 + 4 * F.lane;
#pragma unroll
            for (int j = 0; j < 4; ++j) {
                v[j] = *(const __attribute__((address_space(1))) f32x4*)(cin + 256 * j);
#pragma unroll
                for (int kp = 0; kp < 3; ++kp) v[j] += *(const __attribute__((address_space(1))) f32x4*)(pp + (size_t)kp * NCTX * 1024 + 256 * j);
                *(__attribute__((address_space(1))) f32x4*)(xo + 256 * j) = v[j];
            }
        }
        if (l == 1 && which == 0 && row >= NLAT) {
            const float* pp = (const float*)(P.ws + WS_AR + AR_PART) + (size_t)(row - NLAT) * 1024 + 4 * F.lane;
#pragma unroll
            for (int kp = 0; kp < 4; ++kp)
#pragma unroll
                for (int j = 0; j < 4; ++j) v[j] += *(const __attribute__((address_space(1))) f32x4*)(pp + (size_t)kp * NCTX * 1024 + 256 * j);
        }
#pragma unroll
        for (int j = 0; j < 4; ++j) ss += (v[j][0] * v[j][0] + v[j][1] * v[j][1]) + (v[j][2] * v[j][2] + v[j][3] * v[j][3]);
        ss = wave_sum(ss); const float rinv = rsqrtf(ss * (1.0f / 1024.0f) + EPS);
#pragma unroll
        for (int j = 0; j < 4; ++j) {
            const int col = 4 * F.lane + 256 * j;
            const f32x4 g = *(const __attribute__((address_space(1))) f32x4*)(gn + col), s1 = *(const __attribute__((address_space(1))) f32x4*)(sc + col), s0 = *(const __attribute__((address_space(1))) f32x4*)(sh + col);
            const f32x4 y = v[j] * rinv * g * (s1 + 1.0f) + s0;
            u32x2 w; w.x = cvt_pk_bf16(y[0], y[1]); w.y = cvt_pk_bf16(y[2], y[3]);
            *(__attribute__((address_space(1))) u32x2*)(H + (size_t)row * 1024 + col) = w;
            if (HB && (((row + 2) & 127) < 4)) *(__attribute__((address_space(1))) u32x2*)(HB + (size_t)(4 * ((row + 2) >> 7) + ((row + 2) & 127)) * 1024 + col) = w;
        }
    }
}

__device__ __forceinline__ void phase_scan(const Frame& F, const Params& P, int l) {
    const float* S = (const float*)(P.ws + WS_AR + AR_S); bf16_t* UC = (bf16_t*)(P.ws + WS_AR + AR_UC);
    const float* lam_re = P.in[9]; const float* lam_im = P.in[10]; const float* log_dt = P.in[11];
    const int gw = F.bid * 8 + F.wave, NGW = F.G * 8;
    for (int ww = gw; ww < 256; ww += NGW) {
        const int g = ww >> 3, b = (ww >> 1) & 3, d = ww & 1, p = F.lane; const int gi = (l * 2 + d) * 32 + g;
        const float lr = lam_re[gi * 64 + p], li = lam_im[gi * 64 + p], dt = expf(log_dt[gi]);
        const float mag = expf(32.0f * lr * dt); float sn, cs; sincosf(32.0f * li * dt, &sn, &cs);
        const float aLr = mag * cs, aLi = mag * sn;
        const int ctxb = (NLAT + 256 * b) / 32, latb = 256 * b;
        float cr = 0.f, ci = 0.f;
        auto chunk_of = [&](int j) -> int { return (j < 8) ? (ctxb + (d ? 7 - j : j)) : (latb + (d ? 255 - (j - 8) : (j - 8))); };
        float sr[8], si[8], nr_[8], ni_[8];
#pragma unroll
        for (int q = 0; q < 8; ++q) { const float* sp = S + ((size_t)g * CHPAD + chunk_of(q)) * 256 + d * 128 + p; sr[q] = sp[0]; si[q] = sp[64]; }
        for (int j0 = 0; j0 < 264; j0 += 8) {
            if (j0 + 8 < 264) {
#pragma unroll
                for (int q = 0; q < 8; ++q) { const float* sp = S + ((size_t)g * CHPAD + chunk_of(j0 + 8 + q)) * 256 + d * 128 + p; nr_[q] = sp[0]; ni_[q] = sp[64]; }
            }
#pragma unroll
            for (int q = 0; q < 8; ++q) {
                bf16_t* cp = UC + ((size_t)g * CHPAD + chunk_of(j0 + q)) * 768 + 512 + d * 128 + p;
                cp[0] = (bf16_t)(cvt_pk_bf16(cr, 0.f) & 0xffffu); cp[64] = (bf16_t)(cvt_pk_bf16(ci, 0.f) & 0xffffu);
                const float nr = aLr * cr - aLi * ci + sr[q], ni = aLr * ci + aLi * cr + si[q]; cr = nr; ci = ni;
            }
#pragma unroll
            for (int q = 0; q < 8; ++q) { sr[q] = nr_[q]; si[q] = ni_[q]; }
        }
    }
}

__device__ __forceinline__ s16x4 ld_tr(const unsigned char* p) { return __builtin_bit_cast(s16x4, __builtin_amdgcn_ds_read_tr16_b64_v4i16((LAS s16x4*)p)); }

template <int DV>
__device__ __forceinline__ void attn_pass(const int tid, unsigned char* smem, const bf16_t* Q0, int qpitch, const bf16_t* Kb, int kpitch, const bf16_t* Vb, int vpitch,
                                          int b, int ntiles, float kmax, f32x16 (&o)[DV / 32], float& linv) {
    constexpr int KP = 144, VP = DV * 2 + 64, KBYTES = 64 * KP, VBYTES = 64 * VP, BUF = KBYTES + VBYTES, NV = DV / 64;
    const int lane = tid & 63, wid = __builtin_amdgcn_readfirstlane(tid >> 6), r32 = lane & 31, hi = lane >> 5;
    bf16x8 qf[4];
    { const bf16_t* qp = Q0 + (size_t)(wid * 32 + r32) * qpitch + 8 * hi;
#pragma unroll
      for (int ds = 0; ds < 4; ++ds) qf[ds] = *(const bf16x8*)(qp + 16 * ds); }
    float ssq = 0.f;
#pragma unroll
    for (int ds = 0; ds < 4; ++ds)
#pragma unroll
        for (int j = 0; j < 8; ++j) { const float f = bf2f((unsigned short)qf[ds][j]); ssq += f * f; }
    ssq = sum_x32(ssq);
    const float nshift = -sqrtf(ssq) * kmax;
#pragma unroll
    for (int d0 = 0; d0 < DV / 32; ++d0)
#pragma unroll
        for (int r = 0; r < 16; ++r) o[d0][r] = 0.f;
    float lsum = 0.f;
    const int krow = tid >> 3, kch = tid & 7;
    u32x4 kreg, vreg[NV];
    auto tile_row = [&](int kt) -> size_t { return kt < 4 ? (size_t)(NLAT + 256 * b + 64 * kt) : (size_t)(SEQ * b + 64 * (kt - 4)); };
    auto gload = [&](int kt) {
        const size_t rb = tile_row(kt);
        kreg = *(const u32x4*)(Kb + (rb + krow) * kpitch + 8 * kch);
#pragma unroll
        for (int i = 0; i < NV; ++i) { const int item = tid + 512 * i; const int vr = (DV == 64) ? (item >> 3) : (item >> 4), vc = (DV == 64) ? (item & 7) : (item & 15);
            vreg[i] = *(const u32x4*)(Vb + (rb + vr) * vpitch + 8 * vc); }
    };
    auto lwrite = [&](int buf) {
        unsigned char* Ks = smem + buf * BUF; unsigned char* Vs = Ks + KBYTES;
        *(u32x4*)(Ks + krow * KP + 16 * kch) = kreg;
#pragma unroll
        for (int i = 0; i < NV; ++i) { const int item = tid + 512 * i; const int vr = (DV == 64) ? (item >> 3) : (item >> 4), vc = (DV == 64) ? (item & 7) : (item & 15);
            *(u32x4*)(Vs + vr * VP + 16 * vc) = vreg[i]; }
    };
    gload(0); lwrite(0); __syncthreads();
    const int nhalf = (lane >> 4) & 1, q4 = (lane & 15) >> 2, p4 = lane & 3;
    for (int kt = 0; kt < ntiles; ++kt) {
        if (kt + 1 < ntiles) gload(kt + 1);
        const unsigned char* Ks = smem + (kt & 1) * BUF; const unsigned char* Vs = Ks + KBYTES;
        const unsigned char* kp = Ks + r32 * KP + hi * 16;
        bf16x8 pf[2][2];
#pragma unroll
        for (int kb = 0; kb < 2; ++kb) {
            f32x16 s;
#pragma unroll
            for (int r = 0; r < 16; ++r) s[r] = nshift;
#pragma unroll
            for (int ds = 0; ds < 4; ++ds) {
                const bf16x8 kf = *(const bf16x8*)(kp + kb * 32 * KP + ds * 32);
                s = __builtin_amdgcn_mfma_f32_32x32x16_bf16(kf, qf[ds], s, 0, 0, 0);
            }
            float ls = 0.f;
#pragma unroll
            for (int r = 0; r < 16; ++r) { s[r] = __builtin_amdgcn_exp2f(s[r]); ls += s[r]; }
            lsum += ls;
#pragma unroll
            for (int j = 0; j < 2; ++j) {
                u32x4 w0;
                w0.x = cvt_pk_bf16(s[8 * j + 0], s[8 * j + 1]); w0.y = cvt_pk_bf16(s[8 * j + 2], s[8 * j + 3]); w0.z = cvt_pk_bf16(s[8 * j + 4], s[8 * j + 5]); w0.w = cvt_pk_bf16(s[8 * j + 6], s[8 * j + 7]);
                pf[kb][j] = __builtin_bit_cast(bf16x8, w0);
            }
        }
        const unsigned char* vp = Vs + (4 * hi + q4) * VP + (16 * nhalf + 4 * p4) * 2;
#pragma unroll
        for (int d0 = 0; d0 < DV / 32; ++d0) {
#pragma unroll
            for (int kb = 0; kb < 2; ++kb)
#pragma unroll
                for (int j = 0; j < 2; ++j) {
                    const unsigned char* a = vp + (32 * kb + 16 * j) * VP + d0 * 64;
                    const s16x4 lo = ld_tr(a), h4 = ld_tr(a + 8 * VP);
                    const bf16x8 vf = (bf16x8){lo[0], lo[1], lo[2], lo[3], h4[0], h4[1], h4[2], h4[3]};
                    o[d0] = __builtin_amdgcn_mfma_f32_32x32x16_bf16(vf, pf[kb][j], o[d0], 0, 0, 0);
                }
            if (d0 & 1) __builtin_amdgcn_sched_barrier(0);
        }
        if (kt + 1 < ntiles) lwrite((kt + 1) & 1);
        __syncthreads();
    }
    lsum = sum_x32(lsum);
    linv = 1.0f / lsum;
}

__device__ __forceinline__ void attn_pass_A2(const int tid, unsigned char* smem, const bf16_t* Q0w, int qpitch, const bf16_t* Kb, int kpitch, const bf16_t* Vb, int vpitch,
                                             int b, int ntiles, float kmax, f32x16 (&o)[2][2], float (&linv)[2]) {
    constexpr int KP = 144, VP = 192, KBYTES = 64 * KP, VBYTES = 64 * VP, BUF = KBYTES + VBYTES;
    const int lane = tid & 63, r32 = lane & 31, hi = lane >> 5;
    float nshift[2], lsum[2] = {0.f, 0.f};
    unsigned char* qs = smem + 2 * BUF + ((tid >> 6) * 64 + r32) * KP + hi * 16;
#pragma unroll
    for (int qb = 0; qb < 2; ++qb) {
        const bf16_t* qp = Q0w + (size_t)(32 * qb + r32) * qpitch + 8 * hi; float ssq = 0.f;
#pragma unroll
        for (int ds = 0; ds < 4; ++ds) { const bf16x8 qv = *(const bf16x8*)(qp + 16 * ds); *(bf16x8*)(qs + qb * 32 * KP + ds * 32) = qv;
#pragma unroll
            for (int j = 0; j < 8; ++j) { const float f = bf2f((unsigned short)qv[j]); ssq += f * f; } }
        nshift[qb] = -sqrtf(sum_x32(ssq)) * kmax;
#pragma unroll
        for (int d0 = 0; d0 < 2; ++d0)
#pragma unroll
            for (int r = 0; r < 16; ++r) o[qb][d0][r] = 0.f;
    }
    const int krow = tid >> 3, kch = tid & 7;
    u32x4 kreg, vreg;
    auto gload = [&](int kt) {
        const size_t rb = kt < 4 ? (size_t)(NLAT + 256 * b + 64 * kt) : (size_t)(SEQ * b + 64 * (kt - 4));
        kreg = *(const u32x4*)(Kb + (rb + krow) * kpitch + 8 * kch); vreg = *(const u32x4*)(Vb + (rb + krow) * vpitch + 8 * kch);
    };
    auto lwrite = [&](int buf) { unsigned char* Ks = smem + buf * BUF; *(u32x4*)(Ks + krow * KP + 16 * kch) = kreg; *(u32x4*)(Ks + KBYTES + krow * VP + 16 * kch) = vreg; };
    gload(0); lwrite(0); __syncthreads();
    const int nhalf = (lane >> 4) & 1, q4 = (lane & 15) >> 2, p4 = lane & 3;
    for (int kt = 0; kt < ntiles; ++kt) {
        if (kt + 1 < ntiles) gload(kt + 1);
        const unsigned char* Ks = smem + (kt & 1) * BUF; const unsigned char* Vs = Ks + KBYTES;
        const unsigned char* kp = Ks + r32 * KP + hi * 16;
        const unsigned char* vp = Vs + (4 * hi + q4) * VP + (16 * nhalf + 4 * p4) * 2;
#pragma unroll
        for (int kb = 0; kb < 2; ++kb) {
            bf16x8 pf[2][2];
            {
                f32x16 s0, s1;
#pragma unroll
                for (int r = 0; r < 16; ++r) { s0[r] = nshift[0]; s1[r] = nshift[1]; }
#pragma unroll
                for (int ds = 0; ds < 4; ++ds) {
                    const bf16x8 kf = *(const bf16x8*)(kp + kb * 32 * KP + ds * 32);
                    const bf16x8 q0 = *(const bf16x8*)(qs + ds * 32), q1 = *(const bf16x8*)(qs + 32 * KP + ds * 32);
                    s0 = __builtin_amdgcn_mfma_f32_32x32x16_bf16(kf, q0, s0, 0, 0, 0);
                    s1 = __builtin_amdgcn_mfma_f32_32x32x16_bf16(kf, q1, s1, 0, 0, 0);
                }
                float l0 = 0.f, l1 = 0.f;
#pragma unroll
                for (int r = 0; r < 16; ++r) { s0[r] = __builtin_amdgcn_exp2f(s0[r]); l0 += s0[r]; }
#pragma unroll
                for (int r = 0; r < 16; ++r) { s1[r] = __builtin_amdgcn_exp2f(s1[r]); l1 += s1[r]; }
                lsum[0] += l0; lsum[1] += l1;
#pragma unroll
                for (int j = 0; j < 2; ++j) {
                    u32x4 w0, w1;
                    w0.x = cvt_pk_bf16(s0[8 * j + 0], s0[8 * j + 1]); w0.y = cvt_pk_bf16(s0[8 * j + 2], s0[8 * j + 3]); w0.z = cvt_pk_bf16(s0[8 * j + 4], s0[8 * j + 5]); w0.w = cvt_pk_bf16(s0[8 * j + 6], s0[8 * j + 7]);
                    w1.x = cvt_pk_bf16(s1[8 * j + 0], s1[8 * j + 1]); w1.y = cvt_pk_bf16(s1[8 * j + 2], s1[8 * j + 3]); w1.z = cvt_pk_bf16(s1[8 * j + 4], s1[8 * j + 5]); w1.w = cvt_pk_bf16(s1[8 * j + 6], s1[8 * j + 7]);
                    pf[0][j] = __builtin_bit_cast(bf16x8, w0); pf[1][j] = __builtin_bit_cast(bf16x8, w1);
                }
            }
            __builtin_amdgcn_sched_barrier(0);
#pragma unroll
            for (int d0 = 0; d0 < 2; ++d0)
#pragma unroll
                for (int j = 0; j < 2; ++j) {
                    const unsigned char* a = vp + (32 * kb + 16 * j) * VP + d0 * 64;
                    const s16x4 lo = ld_tr(a), h4 = ld_tr(a + 8 * VP);
                    const bf16x8 vf = (bf16x8){lo[0], lo[1], lo[2], lo[3], h4[0], h4[1], h4[2], h4[3]};
                    o[0][d0] = __builtin_amdgcn_mfma_f32_32x32x16_bf16(vf, pf[0][j], o[0][d0], 0, 0, 0);
                    o[1][d0] = __builtin_amdgcn_mfma_f32_32x32x16_bf16(vf, pf[1][j], o[1][d0], 0, 0, 0);
                }
            __builtin_amdgcn_sched_barrier(0);
        }
        if (kt + 1 < ntiles) lwrite((kt + 1) & 1);
        __syncthreads();
    }
    linv[0] = 1.0f / sum_x32(lsum[0]); linv[1] = 1.0f / sum_x32(lsum[1]);
}

__device__ __forceinline__ void attn_unit_A2(const Frame& F, const Params& P, int l, int b, int h, size_t qrow0, int nq, int ntiles, float kmax, size_t ooff) {
    bf16_t* YAB = (bf16_t*)(P.ws + WS_AR + AR_YAB); const bf16_t* KA = (const bf16_t*)(P.ws + WS_AR + AR_KA); const bf16_t* VA = (const bf16_t*)(P.ws + WS_AR + AR_VA);
    f32x16 o[2][2]; float linv[2];
    { const int wrow = (F.wave * 64 < nq) ? F.wave * 64 : (F.wave - 4) * 64;
      attn_pass_A2(F.tid, F.lds, YAB + (qrow0 + wrow) * 1024 + 64 * h, 1024, KA + 64 * (h >> 2), 128, VA + 64 * (h >> 2), 128, b, ntiles, kmax, o, linv); }
    int t2 = F.tid; asm volatile("" : "+v"(t2));
    const int r32 = t2 & 31, hi = (t2 >> 5) & 1, wv = t2 >> 6;
    if (wv * 64 < nq) {
#pragma unroll
        for (int qb = 0; qb < 2; ++qb) {
            bf16_t* op = YAB + ooff + (qrow0 + wv * 64 + 32 * qb + r32) * 1024 + 64 * h + 4 * hi;
#pragma unroll
            for (int d0 = 0; d0 < 2; ++d0)
#pragma unroll
                for (int rg = 0; rg < 4; ++rg) {
                    u32x2 w; w.x = cvt_pk_bf16(o[qb][d0][4 * rg] * linv[qb], o[qb][d0][4 * rg + 1] * linv[qb]); w.y = cvt_pk_bf16(o[qb][d0][4 * rg + 2] * linv[qb], o[qb][d0][4 * rg + 3] * linv[qb]);
                    *(u32x2*)(op + 32 * d0 + 8 * rg) = w;
                }
        }
    }
}

__device__ __forceinline__ void attn_unit_C(const Frame& F, const Params& P, int l, int b, int h, size_t qrow0, int ntiles, float kmax, size_t ooff) {
    bf16_t* YD = (bf16_t*)(P.ws + WS_AR + AR_YD); const bf16_t* KC = (const bf16_t*)(P.ws + WS_AR + AR_KC); const bf16_t* VC = (const bf16_t*)(P.ws + WS_AR + AR_VC);
#pragma unroll 1
    for (int sub = 0; sub < 2; ++sub) {
        f32x16 o[4]; float linv;
        attn_pass<128>(F.tid, F.lds, YD + qrow0 * 1024 + 128 * h + 64 * sub, 1024, KC + 128 * h + 64 * sub, 512, VC + 128 * h, 512, b, ntiles, kmax, o, linv);
        int t2 = F.tid; asm volatile("" : "+v"(t2));
        const int r32 = t2 & 31, hi = (t2 >> 5) & 1, wv = t2 >> 6;
        float* st = (float*)(P.ws + WS_AR + AR_O1) + (size_t)F.bid * 32768 + (size_t)t2 * 4;
        if (sub == 0) {
#pragma unroll
            for (int d0 = 0; d0 < 4; ++d0)
#pragma unroll
                for (int rg = 0; rg < 4; ++rg)
                    *(f32x4*)(st + (size_t)(d0 * 4 + rg) * 2048) = (f32x4){o[d0][4 * rg] * linv, o[d0][4 * rg + 1] * linv, o[d0][4 * rg + 2] * linv, o[d0][4 * rg + 3] * linv};
        } else {
            const float* lv = P.in[19] + l * 256 + (t2 & 63);
            const float lam_init = (l == 0) ? 0.2f : 0.35550906f;
            const float lam = expf(wave_sum(lv[0] * lv[64])) - expf(wave_sum(lv[128] * lv[192])) + lam_init;
            const float nl = -lam * linv; float ss = 0.f;
#pragma unroll
            for (int d0 = 0; d0 < 4; ++d0)
#pragma unroll
                for (int rg = 0; rg < 4; ++rg) {
                    const f32x4 s1 = *(const f32x4*)(st + (size_t)(d0 * 4 + rg) * 2048);
#pragma unroll
                    for (int e = 0; e < 4; ++e) { const float dd = s1[e] + nl * o[d0][4 * rg + e]; o[d0][4 * rg + e] = dd; ss += dd * dd; }
                }
            ss = sum_x32(ss);
            const float rn = rsqrtf(ss * (1.0f / 128.0f) + EPS) * (1.0f - lam_init);
            const float* go = P.in[20] + l * 128;
            bf16_t* op = YD + ooff + (qrow0 + wv * 32 + r32) * 1024 + 128 * h + 4 * hi;
#pragma unroll
            for (int d0 = 0; d0 < 4; ++d0)
#pragma unroll
                for (int rg = 0; rg < 4; ++rg) {
                    const f32x4 gv = *(const f32x4*)(go + 32 * d0 + 8 * rg + 4 * hi);
                    u32x2 w; w.x = cvt_pk_bf16(o[d0][4 * rg] * rn * gv[0], o[d0][4 * rg + 1] * rn * gv[1]); w.y = cvt_pk_bf16(o[d0][4 * rg + 2] * rn * gv[2], o[d0][4 * rg + 3] * rn * gv[3]);
                    *(u32x2*)(op + 32 * d0 + 8 * rg) = w;
                }
        }
    }
}

__device__ __forceinline__ void phase_attn(const Frame& F0, const Params& P, int l, size_t ooffA, size_t ooffC) {
    const int total = (l == 0) ? 1072 : 1024;
    for (int i = F0.bid; i < total; i += F0.G) {
        Frame F = F0; { int t = F0.tid; asm volatile("" : "+v"(t)); F.tid = t; F.lane = t & 63; F.wave = __builtin_amdgcn_readfirstlane(t >> 6); }
        int isC, b, h, nt, nq; size_t qrow0;
        if (i < 512) { const int combo = ((i >> 8) << 3) | (i & 7), qb = (i >> 3) & 31; isC = 1; b = combo >> 2; h = combo & 3; qrow0 = (size_t)b * SEQ + 256 * qb; nt = 132; nq = 256; }
        else if (i < 1024) { const int u = i - 512, w = u & 255, slot = w >> 3, combo = (u >> 8) * 16 + (w & 7) * 2 + (slot >> 4); isC = 0; b = combo >> 3; h = combo & 7; qrow0 = (size_t)b * SEQ + 512 * (slot & 15); nt = 132; nq = 512; }
        else { const int u = i - 1024, r = u % 12; b = u / 12; isC = r < 4; h = isC ? r : r - 4; qrow0 = (size_t)NLAT + 256 * b; nt = 4; nq = 256; }
        const float kmax = 8.08f * wave_max(fabsf(P.in[8][(l * 4 + (isC ? 3 : 1)) * 64 + F.lane]));
        if (isC) attn_unit_C(F, P, l, b, h, qrow0, nt, kmax, ooffC); else attn_unit_A2(F, P, l, b, h, qrow0, nq, nt, kmax, ooffA);
    }
}

__device__ __forceinline__ void phase_fixup(const Frame& F, const Params& P, int l, int nrows) {
    const bf16_t* UB = (const bf16_t*)(P.ws + WS_AR + AR_UB); bf16_t* ACT = (bf16_t*)(P.ws + WS_AR + AR_ACT);
    const float* cw = P.in[24] + (size_t)l * 3 * 5632; const float* cb = P.in[25] + (size_t)l * 5632;
    const int nitems = NBGRP * 2 * 352;
    for (int it = F.bid * 512 + F.tid; it < nitems; it += F.G * 512) {
        const int fc = it % 352, js = it / 352, j = js >> 1, sd = js & 1, f0 = 8 * fc;
        const int row = 128 * j - 1 + sd;
        if (row < 0 || row >= nrows) continue;
        const int tpos = (row < NLAT) ? (row & (SEQ - 1)) : ((row - NLAT) & (CTXL - 1)), seqlen = (row < NLAT) ? SEQ : CTXL;
        const int ca = 256 * (f0 >> 7) + (f0 & 127);
        const bf16_t* ub = UB + (size_t)(4 * j + sd) * 5632 + ca;
        const u32x4 z = (u32x4){0, 0, 0, 0};
        const u32x4 pa = (tpos > 0) ? *(const u32x4*)(ub) : z, pg = (tpos > 0) ? *(const u32x4*)(ub + 128) : z;
        const u32x4 ca_ = *(const u32x4*)(ub + 5632), cg_ = *(const u32x4*)(ub + 5632 + 128);
        const u32x4 na = (tpos + 1 < seqlen) ? *(const u32x4*)(ub + 11264) : z, ng = (tpos + 1 < seqlen) ? *(const u32x4*)(ub + 11264 + 128) : z;
        float o[8];
#pragma unroll
        for (int i = 0; i < 4; ++i) {
            const int c0 = f0 + 2 * i, c1 = c0 + 1;
            const float a0 = bflo(pa[i]) * cw[c0] + bflo(ca_[i]) * cw[5632 + c0] + bflo(na[i]) * cw[11264 + c0] + cb[c0];
            const float a1 = bfhi(pa[i]) * cw[c1] + bfhi(ca_[i]) * cw[5632 + c1] + bfhi(na[i]) * cw[11264 + c1] + cb[c1];
            const float g0 = bflo(pg[i]) * cw[2816 + c0] + bflo(cg_[i]) * cw[5632 + 2816 + c0] + bflo(ng[i]) * cw[11264 + 2816 + c0] + cb[2816 + c0];
            const float g1 = bfhi(pg[i]) * cw[2816 + c1] + bfhi(cg_[i]) * cw[5632 + 2816 + c1] + bfhi(ng[i]) * cw[11264 + 2816 + c1] + cb[2816 + c1];
            o[2 * i] = g0 * sigmoidf_(g0) * a0; o[2 * i + 1] = g1 * sigmoidf_(g1) * a1;
        }
        u32x4 w; w.x = cvt_pk_bf16(o[0], o[1]); w.y = cvt_pk_bf16(o[2], o[3]); w.z = cvt_pk_bf16(o[4], o[5]); w.w = cvt_pk_bf16(o[6], o[7]);
        *(u32x4*)(ACT + (size_t)row * 2816 + f0) = w;
    }
}

template <class T> __device__ __forceinline__ T* as_global(T* p) { return (T*)(__attribute__((address_space(1))) T*)p; }
#ifndef PH_MASK
#define PH_MASK 0x1ffff
#endif
#define PHM(k) ((PH_MASK >> (k)) & 1)
#ifndef REP_MASK
#define REP_MASK 0
#endif
constexpr int NPHASE = 33;
constexpr int LDS_BYTES = 147456;

__global__ void __launch_bounds__(512, 2) mega_fwd(Params Pk) {
    extern __shared__ __attribute__((aligned(16))) unsigned char lds[];
    Params P = Pk;
#pragma unroll
    for (int i = 0; i < 27; ++i) P.in[i] = as_global(Pk.in[i]);
    P.out = as_global(Pk.out); P.ws = as_global(Pk.ws);
    cg::grid_group grid = cg::this_grid();
    const int wave_s = __builtin_amdgcn_readfirstlane(threadIdx.x >> 6);
    volatile LAS unsigned* bst = (volatile LAS unsigned*)((LAS unsigned char*)lds + 131072 + 1024);
    if (threadIdx.x < 2) bst[threadIdx.x] = 0u;
    __syncthreads();
    (void)xcd_barrier_post((unsigned*)(P.ws + WS_BAR), bst);
    for (int ph = P.ph_lo; ph < P.ph_hi; ++ph) {
        if (ph > 0 && (((ph - 1) & 15) >= 13 || ((ph - 1) & 15) == 5 || ((ph - 1) & 15) == 11)) continue;
        const int nrep = (ph > 0 && P.rep_q == ((ph - 1) & 15)) ? P.rep_n + 1 : 1;
        for (int rep = 0; rep < nrep; ++rep) {
        int tid_l = wave_s * 64 + (int)__builtin_amdgcn_mbcnt_hi(~0u, __builtin_amdgcn_mbcnt_lo(~0u, 0u)), bid_l = blockIdx.x, g_l = gridDim.x; unsigned char* ws = P.ws;
        asm volatile("" : "+v"(tid_l)); asm volatile("" : "+s"(bid_l), "+s"(g_l), "+s"(ws));
        ws = as_global(ws);
        Frame F; F.lds = lds; F.tid = tid_l; F.lane = F.tid & 63; F.wave = __builtin_amdgcn_readfirstlane(F.tid >> 6); F.G = g_l; F.bid = bid_l;
        LAS unsigned char* ldsl = (LAS unsigned char*)lds;
        unsigned char* AR = ws + WS_AR; unsigned char* Wb = ws + WS_W;
        bf16_t* H = (bf16_t*)(ws + WS_H); float* XC = (float*)(ws + WS_XC); const float* MODall = (const float*)(ws + WS_MOD);
        if (ph == 0) {
            if (PHM(16)) { phase_adaln(F, P); prep_layer(F, P, 0); }
        } else {
            const int l = (ph - 1) >> 4, q = (ph - 1) & 15; const bool last = (l == 1);
            const float* MOD = MODall + l * 5 * 6144;
            const int nM_out = last ? 128 : 132;
            switch (q) {
            case 0: if (PHM(0)) { phase_norm(F, P, l, 0, MT, nullptr); if (l == 1) prep_layer(F, P, 1); } break;
            case 1: if (PHM(1)) {
                SchedPlain S{H, (const bf16_t*)(Wb + W_WIN), 1024, 1024, 132, 11, 16, F.G, F.bid, 0};
                EpiG1 E{(bf16_t*)(AR + AR_YAB), (bf16_t*)(AR + AR_YD), (bf16_t*)(AR + AR_KA), (bf16_t*)(AR + AR_VA), (bf16_t*)(AR + AR_KC), (bf16_t*)(AR + AR_VC), (bf16_t*)(AR + AR_UC),
                        P.in[8] + l * 256, (const float*)(ws + WS_TAB)};
                pg8::gemm_phase<EpiG1, SchedPlain, true, true>(ldsl, F.tid, 1024, 1024, S, E);
            } break;
            case 2: if (PHM(2)) {
                SchedS5 S{(const bf16_t*)(AR + AR_UC), (const bf16_t*)(Wb + W_M1), 512, 1, 8, F.G, F.bid, 5};
                EpiS E{(float*)(AR + AR_S)};
                pg8::gemm_phase<EpiS, SchedS5, true, true>(ldsl, F.tid, 768, 512, S, E);
            } break;
            case 3: if (PHM(3)) phase_scan(F, P, l); break;
            case 4: if (PHM(4)) {
                SchedS5 S{(const bf16_t*)(AR + AR_UC), (const bf16_t*)(Wb + W_TM2), 768, 2, 12, F.G, F.bid, last ? 4 : 5};
                EpiY E{(bf16_t*)(AR + AR_YD) + 512};
                pg8::gemm_phase<EpiY, SchedS5, true, true>(ldsl, F.tid, 768, 768, S, E);
            } break;
            case 6: if (PHM(6)) {
                {

                SchedPlain S{(const bf16_t*)(AR + AR_YD) + 512, (const bf16_t*)(Wb + W_GLU), 1024, 512, nM_out, 2, 8, F.G, F.bid, 0};
                EpiGLU E{(const bf16_t*)(AR + AR_YD) + 512, (bf16_t*)(AR + AR_YAB) + 512, P.in[18] + l * 512};
                pg8::gemm_phase<EpiGLU, SchedPlain, true, true>(ldsl, F.tid, 1024, 512, S, E);
                            }
                const bool dummy = rep + 1 < nrep;
                phase_attn(F, P, l, dummy ? (size_t)(250 * MiB - AR_YAB) / 2 : 0, dummy ? (size_t)(250 * MiB - AR_YD) / 2 : 0);
            } break;
            case 7: if (PHM(7)) {
                SchedMerge S{H, (const bf16_t*)(AR + AR_YAB), (const bf16_t*)(AR + AR_YD), (const bf16_t*)(Wb + W_BCAT), last ? 0 : 48, F.G, F.bid};
                EpiMerge E{(bf16_t*)(AR + AR_M), (float*)(AR + AR_SM) + (size_t)F.bid * 65536, (unsigned*)(AR + AR_SG) + (size_t)F.bid * 32768, F.tid, (bf16_t*)(AR + AR_MCTX)};
                pg8::gemm_phase<EpiMerge, SchedMerge, true, true>(ldsl, F.tid, 1024, 1536, S, E);
            } break;
            case 8: if (PHM(8)) {
                SchedG4 S{(const bf16_t*)(AR + AR_M), (const bf16_t*)(AR + AR_MCTX), (const bf16_t*)(Wb + W_OUT), last ? 0 : 48, F.G, F.bid};
                EpiRes E{l == 0 ? P.in[0] : P.out, l == 0 ? P.in[2] : XC, P.out, XC, MOD, 2048, (float*)(AR + AR_PG4)};
                pg8::gemm_phase<EpiRes, SchedG4, true, true>(ldsl, F.tid, 1024, 1024, S, E);
            } break;
            case 9: if (PHM(9)) phase_norm(F, P, l, 1, last ? NLAT : MT, (bf16_t*)(AR + AR_HB)); break;
            case 10: if (PHM(10)) {
                SchedUp S{H, (const bf16_t*)(AR + AR_HB), (const bf16_t*)(Wb + W_UP), nM_out, F.G, F.bid};
                EpiUpConv E{(bf16_t*)(AR + AR_ACT), last ? NLAT : MT, P.in[24] + (size_t)l * 3 * 5632, P.in[25] + (size_t)l * 5632};
                pg8::gemm_phase<EpiUpConv, SchedUp, true, true, true>(ldsl, F.tid, 1024, 1024, S, E);
            } break;
            case 11: if (PHM(11)) phase_fixup(F, P, l, last ? NLAT : MT); break;
            case 12: if (PHM(12)) {
                EpiRes E{P.out, XC, P.out, XC, MOD, 5120, (float*)(AR + AR_PART)};
                SchedG6c S{(const bf16_t*)(AR + AR_ACT), (const bf16_t*)(Wb + W_DOWN), F.G, F.bid, last ? 0 : 64};
                pg8::gemm_phase<EpiRes, SchedG6c, true, true>(ldsl, F.tid, 2816, 2816, S, E);
            } break;
            default: break;
            }
        }
        if (rep + 1 < nrep) __syncthreads();
        }
        if (ph + 1 < P.ph_hi && ph < NPHASE - 4) { if (ph == P.ph_lo) grid.sync(); else { XcdBarrier xb; xb.bar = (unsigned*)(P.ws + WS_BAR); xb.x = xb_xcc_id(); xb.st = (volatile LAS unsigned*)((LAS unsigned char*)lds + 131072 + 1024); xcd_barrier(xb); } }
    }
}

extern "C" void kernel_launch(void* const* d_in, const int* in_sizes, int n_in, void* d_out, int out_size, void* d_ws, size_t ws_size, hipStream_t stream) {
    static int grid = 0;
    if (grid == 0) {
        int dev = 0, cus = 0, per_cu = 0;
        if (hipGetDevice(&dev) != hipSuccess || hipDeviceGetAttribute(&cus, hipDeviceAttributeMultiprocessorCount, dev) != hipSuccess) { fprintf(stderr, "device query failed\n"); grid = -1; return; }
        if (hipFuncSetAttribute((const void*)mega_fwd, hipFuncAttributeMaxDynamicSharedMemorySize, LDS_BYTES) != hipSuccess) { fprintf(stderr, "hipFuncSetAttribute failed\n"); grid = -1; return; }
        if (hipOccupancyMaxActiveBlocksPerMultiprocessor(&per_cu, (const void*)mega_fwd, 512, LDS_BYTES) != hipSuccess || per_cu < 1) { fprintf(stderr, "occupancy query: %d\n", per_cu); per_cu = 1; }
        (void)hipGetLastError();
        grid = cus > 256 ? 256 : cus;
        if (n_in != 27 || out_size != NLAT * DM || ws_size < WS_TOTAL) { fprintf(stderr, "kernel_launch: unexpected shapes (n_in %d out %d ws %zu need %zu)\n", n_in, out_size, ws_size, (size_t)WS_TOTAL); grid = -1; return; }
    }
    if (grid < 0) return;
    (void)hipMemsetAsync((char*)d_ws + WS_MOD, 0, 512 * 1024, stream);
    Params p{};
    for (int i = 0; i < 27; ++i) p.in[i] = (const float*)d_in[i];
    p.out = (float*)d_out; p.ws = (unsigned char*)d_ws;
    p.rep_q = -1; p.rep_n = 0;
#ifdef PROBE_Q
    p.rep_q = PROBE_Q; p.rep_n = 1;
#endif
#if N_LAUNCH_MODE == 1
    p.ph_lo = 0; p.ph_hi = NPHASE;
    void* args[] = {&p};
    hipError_t e = hipLaunchCooperativeKernel((const void*)mega_fwd, dim3(grid), dim3(512), args, LDS_BYTES, stream);
    if (e != hipSuccess) fprintf(stderr, "cooperative launch failed: %s (grid %d)\n", hipGetErrorString(e), grid);
#else
    for (int ph = 0; ph < NPHASE; ++ph) {
        p.ph_lo = ph; p.ph_hi = ph + 1;
        hipLaunchKernelGGL(mega_fwd, dim3(grid), dim3(512), LDS_BYTES, stream, p);
    }
#endif
}
```

```cpp
#include <hip/hip_runtime.h>
#include <hip/hip_cooperative_groups.h>
#include <cstdio>
#include <cstdint>
namespace cg = cooperative_groups;

#ifndef N_LAUNCH_MODE
#define N_LAUNCH_MODE 1
#endif

#define LAS __attribute__((address_space(3)))
typedef unsigned short bf16_t;
typedef short bf16x8 __attribute__((ext_vector_type(8)));
typedef short s16x4 __attribute__((ext_vector_type(4)));
typedef float f32x4 __attribute__((ext_vector_type(4)));
typedef float f32x2 __attribute__((ext_vector_type(2)));
typedef float f32x16 __attribute__((ext_vector_type(16)));
typedef unsigned u32x4 __attribute__((ext_vector_type(4)));
typedef unsigned u32x2 __attribute__((ext_vector_type(2)));

constexpr int DM = 1024, NBATCH = 4, SEQ = 8192, CTXL = 256;
constexpr int NLAT = NBATCH * SEQ, NCTX = NBATCH * CTXL, MT = NLAT + NCTX;
constexpr int DFF = 2816, NIN = 5888, NMIX = 2816;
constexpr int NCHUNK = MT / 32, CHPAD = 1280;
constexpr float EPS = 1e-6f;
constexpr float QSCALE = 0.125f * 1.4426950408889634f;

constexpr size_t MiB = 1u << 20;
constexpr size_t WS_MOD = 0;
constexpr size_t WS_BAR = 384 * 1024;
constexpr size_t WS_TAB = 512 * 1024;
constexpr size_t WS_W = 1 * MiB;
constexpr size_t W_WIN = 0, W_BCAT = W_WIN + (size_t)2816 * 1024 * 2, W_GLU = W_BCAT + (size_t)3 * 1024 * 1536 * 2, W_OUT = W_GLU + (size_t)512 * 512 * 2,
                 W_UP = W_OUT + (size_t)1024 * 1024 * 2, W_DOWN = W_UP + (size_t)5632 * 1024 * 2, W_M1 = W_DOWN + (size_t)1024 * 2816 * 2,
                 W_TM2 = W_M1 + (size_t)32 * 256 * 512 * 2, W_END = W_TM2 + (size_t)32 * 512 * 768 * 2;
static_assert(W_END <= 66 * MiB, "weights");
constexpr size_t WS_H = 67 * MiB;
constexpr size_t WS_XC = 133 * MiB;
constexpr size_t WS_AR = 137 * MiB;
constexpr size_t AR_YAB = 0, AR_YD = 66 * MiB, AR_KA = 132 * MiB, AR_VA = 141 * MiB, AR_KC = 150 * MiB, AR_VC = 183 * MiB, AR_UC = 216 * MiB, AR_S = 276 * MiB, AR_END = 316 * MiB;
constexpr size_t AR_O1 = 216 * MiB;
constexpr size_t AR_M = 132 * MiB, AR_SM = 198 * MiB, AR_SG = 262 * MiB;
constexpr size_t AR_ACT = 0, AR_UB = 188 * MiB, AR_HB = 204 * MiB;
constexpr size_t AR_PART = 208 * MiB;
constexpr size_t AR_MCTX = 296 * MiB, AR_PG4 = 302 * MiB;
constexpr int NBGRP = 265;
constexpr size_t WS_TOTAL = WS_AR + AR_END;
static_assert((size_t)32 * CHPAD * 768 * 2 <= 60 * MiB && (size_t)32 * CHPAD * 256 * 4 <= 40 * MiB, "s5 buffers");
static_assert((size_t)MT * 2816 * 2 <= 188 * MiB && AR_UB + (size_t)1280 * 5632 * 2 <= AR_HB && AR_HB + (size_t)1280 * 1024 * 2 <= AR_END, "ffn buffers");

struct Params {
    const float* in[27];
    float* out; unsigned char* ws;
    int ph_lo, ph_hi, rep_q, rep_n;
};

typedef __bf16 bf16x2_t __attribute__((ext_vector_type(2)));
__device__ __forceinline__ unsigned cvt_pk_bf16(float lo, float hi) { f32x2 v = {lo, hi}; bf16x2_t b = __builtin_convertvector(v, bf16x2_t); return __builtin_bit_cast(unsigned, b); }
__device__ __forceinline__ float bf2f(unsigned short b) { return __uint_as_float((unsigned)b << 16); }
__device__ __forceinline__ float bflo(unsigned w) { return __uint_as_float(w << 16); }
__device__ __forceinline__ float bfhi(unsigned w) { return __uint_as_float(w & 0xffff0000u); }
__device__ __forceinline__ float sigmoidf_(float v) { return __builtin_amdgcn_rcpf(1.0f + __builtin_amdgcn_exp2f(-1.4426950408889634f * v)); }
__device__ __forceinline__ float gelu_tanh(float y) { const float u = 1.5957691216057308f * (y + 0.044715f * y * y * y); return y * sigmoidf_(u); }
template <int K> __device__ __forceinline__ float shx(float v) {
    return __uint_as_float((unsigned)__builtin_amdgcn_ds_swizzle((int)__float_as_uint(v), (K << 10) | 0x1f));
}
__device__ __forceinline__ float sum_x32(float v) { auto rr = __builtin_amdgcn_permlane32_swap(__float_as_uint(v), __float_as_uint(v), false, false); return __uint_as_float(rr[0]) + __uint_as_float(rr[1]); }
__device__ __forceinline__ float max_x32(float v) { auto rr = __builtin_amdgcn_permlane32_swap(__float_as_uint(v), __float_as_uint(v), false, false); return fmaxf(__uint_as_float(rr[0]), __uint_as_float(rr[1])); }
__device__ __forceinline__ float wave_sum(float v) {
    v += shx<1>(v); v += shx<2>(v); v += shx<4>(v); v += shx<8>(v); v += shx<16>(v); return sum_x32(v);
}
__device__ __forceinline__ float wave_max(float v) {
    v = fmaxf(v, shx<1>(v)); v = fmaxf(v, shx<2>(v)); v = fmaxf(v, shx<4>(v)); v = fmaxf(v, shx<8>(v)); v = fmaxf(v, shx<16>(v)); return max_x32(v);
}

namespace pg8 {
constexpr int BM = 256, BK = 64, HALF = 128, HTB = HALF * BK * 2, STAGE_BYTES = 8 * HTB, WGM = 4;
__host__ __device__ __forceinline__ int lds_byte(int r, int c) { const int st = (r >> 4) * 2 + (c >> 5), rr = r & 15, cc = c & 31, ob = rr * 64 + cc * 2; return st * 1024 + (ob ^ (((ob >> 9) & 1) << 5)); }
__host__ __device__ __forceinline__ void stage_rc(int b, int& R, int& C) { const int st = b / 1024, sb = b % 1024, swz = sb ^ (((sb >> 9) & 1) << 5); R = (st >> 1) * 16 + swz / 64; C = (st & 1) * 32 + (swz % 64) / 2; }

struct Unit { const bf16_t* A; const bf16_t* B; int nt; int pm; int pn; int mode; };

__device__ __forceinline__ bool tile_of(int L, int nM, int nN, int& pm, int& pn) {
    const int nwg = nM * nN; if (L >= nwg) return false;
    int wgid = (int)L; { const int q = nwg / 8, r = nwg % 8, xcd = wgid % 8, off = wgid / 8; wgid = (xcd < r ? xcd * (q + 1) : r * (q + 1) + (xcd - r) * q) + off; }
    const int nig = WGM * nN, gid = wgid / nig, fm = gid * WGM, gsz = (nM - fm) < WGM ? (nM - fm) : WGM;
    pm = fm + ((wgid % nig) % gsz); pn = (wgid % nig) / gsz; return true;
}

template <class Epi, class Sched, bool ALIGN_EPI, bool SP2, bool PERMA = false>
__device__ __forceinline__ void gemm_phase(LAS unsigned char* lds, const int tid, const int lda, const int ldb, const Sched& S, const Epi& E) {
    const int wid = __builtin_amdgcn_readfirstlane(tid >> 6), lane = tid & 63, wr = wid >> 2, wc = wid & 3, fr = lane & 15, fq = lane >> 4;
    unsigned voffA[2], voffB[2];
#pragma unroll
    for (int i = 0; i < 2; ++i) { int R, C; stage_rc(tid * 16 + i * 8192, R, C);
        const int Ra = PERMA ? (128 * (R >> 6) + 8 * (R & 15) + ((R >> 4) & 3)) : R;
        voffA[i] = (unsigned)(Ra * lda + C) * 2u; voffB[i] = (unsigned)(R * ldb + C) * 2u; }
    const size_t kstep = (size_t)(BK * 2);
    const size_t hsA = (size_t)(PERMA ? 4 : HALF) * lda * 2, hsB = (size_t)HALF * ldb * 2;
    const unsigned ldsw = (unsigned)wid * 1024u;
    const int aoff = lds_byte(wr * 64 + fr, fq * 8), boff = lds_byte(wc * 32 + fr, fq * 8);
#define PG8_SA(b, h) (((b) * 2 + (h)) * HTB)
#define PG8_SB(b, h) ((4 + (b) * 2 + (h)) * HTB)
#define PG8_STAGE(bufoff, gbase, voff) do { _Pragma("unroll") for (int _i = 0; _i < 2; ++_i) \
        __builtin_amdgcn_global_load_lds((const unsigned*)((const char*)(gbase) + (voff)[_i]), (LAS unsigned*)(lds + (bufoff) + ldsw + _i * 8192), 16, 0, 0); } while (0)
#define PG8_LDA(dst, b, h) do { _Pragma("unroll") for (int m = 0; m < 4; ++m) _Pragma("unroll") for (int k = 0; k < 2; ++k) dst[m][k] = *(const LAS bf16x8*)(lds + PG8_SA(b, h) + aoff + m * 2048 + k * 1024); } while (0)
#define PG8_LDB(dst, b, h) do { _Pragma("unroll") for (int n = 0; n < 2; ++n) _Pragma("unroll") for (int k = 0; k < 2; ++k) dst[n][k] = *(const LAS bf16x8*)(lds + PG8_SB(b, h) + boff + n * 2048 + k * 1024); } while (0)
#define PG8_MMA(ai, bj, At, Bt) do { __builtin_amdgcn_s_setprio(1); _Pragma("unroll") for (int m = 0; m < 4; ++m) _Pragma("unroll") for (int n = 0; n < 2; ++n) _Pragma("unroll") for (int k = 0; k < 2; ++k) \
        acc[ai][bj][m][n] = __builtin_amdgcn_mfma_f32_16x16x32_bf16(Bt[n][k], At[m][k], acc[ai][bj][m][n], 0, 0, 0); __builtin_amdgcn_s_setprio(0); } while (0)
#define PG8_WAIT_V(n) asm volatile("s_waitcnt vmcnt(" #n ")" ::: "memory")
#define PG8_WAIT_L(n) asm volatile("s_waitcnt lgkmcnt(" #n ")" ::: "memory")
#define PG8_BAR __builtin_amdgcn_s_barrier()
#define PG8_SCHED __builtin_amdgcn_sched_barrier(0)
    Unit cur, nxt; int ui = 0;
    if (!S.next(0, cur)) return;
    f32x4 acc[2][2][4][2];
#pragma unroll
    for (int a = 0; a < 2; ++a)
#pragma unroll
        for (int b = 0; b < 2; ++b)
#pragma unroll
            for (int m = 0; m < 4; ++m)
#pragma unroll
                for (int n = 0; n < 2; ++n) acc[a][b][m][n] = (f32x4){0.f, 0.f, 0.f, 0.f};
    bf16x8 At[4][2], B0[2][2], B1[2][2];
    const char* cA = (const char*)cur.A; const char* cB = (const char*)cur.B;
    if constexpr (SP2) {
        PG8_STAGE(PG8_SB(0, 0), cB, voffB); PG8_STAGE(PG8_SB(0, 1), cB + hsB, voffB); PG8_STAGE(PG8_SA(0, 0), cA, voffA); PG8_STAGE(PG8_SA(0, 1), cA + hsA, voffA);
        if (wr == 1) PG8_BAR;
        PG8_WAIT_V(2); PG8_BAR;
        PG8_STAGE(PG8_SB(1, 0), cB + kstep, voffB); PG8_STAGE(PG8_SA(1, 0), cA + kstep, voffA); PG8_STAGE(PG8_SB(1, 1), cB + hsB + kstep, voffB);
        PG8_WAIT_V(6); PG8_BAR;
    } else {
        PG8_STAGE(PG8_SB(0, 0), cB, voffB); PG8_STAGE(PG8_SA(0, 0), cA, voffA); PG8_STAGE(PG8_SB(0, 1), cB + hsB, voffB); PG8_STAGE(PG8_SA(0, 1), cA + hsA, voffA);
        if (wr == 1) PG8_BAR;
        PG8_WAIT_V(4); PG8_BAR;
        PG8_STAGE(PG8_SB(1, 0), cB + kstep, voffB); PG8_STAGE(PG8_SA(1, 0), cA + kstep, voffA); PG8_STAGE(PG8_SB(1, 1), cB + hsB + kstep, voffB);
        PG8_WAIT_V(6); PG8_BAR;
    }
    for (;;) {
        const bool has_next = S.next(ui + 1, nxt);
        const char* nA = has_next ? (const char*)nxt.A : cA; const char* nB = has_next ? (const char*)nxt.B : cB;
        const int nt = cur.nt;
        for (int t = 0; t < nt; t += 2) {
            const bool last = (t == nt - 2);
            const char* a1 = cA + (size_t)(t + 1) * kstep;
            const char* a2 = last ? nA : cA + (size_t)(t + 2) * kstep; const char* b2 = last ? nB : cB + (size_t)(t + 2) * kstep;
            const char* a3 = a2 + kstep; const char* b3 = b2 + kstep;
            if constexpr (SP2) {
            PG8_LDB(B0, 0, 0); PG8_LDB(B1, 0, 1); PG8_SCHED; PG8_LDA(At, 0, 0); PG8_STAGE(PG8_SA(1, 1), a1 + hsA, voffA);
            PG8_WAIT_V(8); PG8_WAIT_L(0); PG8_BAR; PG8_MMA(0, 0, At, B0); PG8_MMA(0, 1, At, B1); PG8_BAR; PG8_SCHED;
            PG8_LDA(At, 0, 1); PG8_STAGE(PG8_SB(0, 0), b2, voffB); PG8_STAGE(PG8_SB(0, 1), b2 + hsB, voffB); PG8_STAGE(PG8_SA(0, 0), a2, voffA);
            PG8_WAIT_V(8); PG8_WAIT_L(0); PG8_BAR; PG8_MMA(1, 0, At, B0); PG8_MMA(1, 1, At, B1); PG8_BAR; PG8_SCHED;
            PG8_LDB(B0, 1, 0); PG8_LDB(B1, 1, 1); PG8_SCHED; PG8_LDA(At, 1, 0); PG8_STAGE(PG8_SA(0, 1), a2 + hsA, voffA);
            PG8_WAIT_V(8); PG8_WAIT_L(0); PG8_BAR; PG8_MMA(0, 0, At, B0); PG8_MMA(0, 1, At, B1); PG8_BAR; PG8_SCHED;
            PG8_LDA(At, 1, 1); PG8_STAGE(PG8_SB(1, 0), b3, voffB); PG8_STAGE(PG8_SB(1, 1), b3 + hsB, voffB); PG8_STAGE(PG8_SA(1, 0), a3, voffA);
            PG8_WAIT_V(8); PG8_WAIT_L(0); PG8_BAR; PG8_MMA(1, 0, At, B0); PG8_MMA(1, 1, At, B1); PG8_BAR; PG8_SCHED;
            } else {
            PG8_LDB(B0, 0, 0); PG8_SCHED; PG8_LDA(At, 0, 0); PG8_STAGE(PG8_SA(1, 1), a1 + hsA, voffA);
            PG8_WAIT_L(8); PG8_BAR; PG8_WAIT_L(0); PG8_MMA(0, 0, At, B0); PG8_BAR; PG8_SCHED;
            PG8_LDB(B1, 0, 1); PG8_STAGE(PG8_SB(0, 0), b2, voffB);
            PG8_BAR; PG8_WAIT_L(0); PG8_MMA(0, 1, At, B1); PG8_BAR;
            PG8_LDA(At, 0, 1); PG8_STAGE(PG8_SA(0, 0), a2, voffA);
            PG8_BAR; PG8_WAIT_L(0); PG8_MMA(1, 0, At, B0); PG8_BAR; PG8_SCHED;
            PG8_STAGE(PG8_SB(0, 1), b2 + hsB, voffB);
            PG8_WAIT_V(6); PG8_BAR; PG8_MMA(1, 1, At, B1); PG8_BAR;
            PG8_LDB(B0, 1, 0); PG8_SCHED; PG8_LDA(At, 1, 0); PG8_STAGE(PG8_SA(0, 1), a2 + hsA, voffA);
            PG8_WAIT_L(8); PG8_BAR; PG8_WAIT_L(0); PG8_MMA(0, 0, At, B0); PG8_BAR; PG8_SCHED;
            PG8_LDB(B1, 1, 1); PG8_STAGE(PG8_SB(1, 0), b3, voffB);
            PG8_BAR; PG8_WAIT_L(0); PG8_MMA(0, 1, At, B1); PG8_BAR;
            PG8_LDA(At, 1, 1); PG8_STAGE(PG8_SA(1, 0), a3, voffA);
            PG8_BAR; PG8_WAIT_L(0); PG8_MMA(1, 0, At, B0); PG8_BAR; PG8_SCHED;
            PG8_STAGE(PG8_SB(1, 1), b3 + hsB, voffB);
            PG8_WAIT_V(6); PG8_BAR; PG8_MMA(1, 1, At, B1); PG8_BAR;
            }
        }
        if constexpr (ALIGN_EPI) { if (wr == 0) PG8_BAR; }
        { int frl = fr, fql = fq; asm volatile("" : "+v"(frl), "+v"(fql)); E(acc, cur, wr, wc, frl, fql); }
        if (!has_next) break;
#pragma unroll
        for (int a = 0; a < 2; ++a)
#pragma unroll
            for (int b = 0; b < 2; ++b)
#pragma unroll
                for (int m = 0; m < 4; ++m)
#pragma unroll
                    for (int n = 0; n < 2; ++n) acc[a][b][m][n] = (f32x4){0.f, 0.f, 0.f, 0.f};
        cur = nxt; cA = nA; cB = nB; ++ui;
        if constexpr (ALIGN_EPI) { if (wr == 1) PG8_BAR; }
    }
    PG8_WAIT_V(0);
    if constexpr (!ALIGN_EPI) { if (wr == 0) PG8_BAR; }
    PG8_BAR;
#undef PG8_SA
#undef PG8_SB
#undef PG8_STAGE
#undef PG8_LDA
#undef PG8_LDB
#undef PG8_MMA
#undef PG8_WAIT_V
#undef PG8_WAIT_L
#undef PG8_BAR
#undef PG8_SCHED
}
}
using pg8::Unit;

struct SchedPlain {
    const bf16_t* A; const bf16_t* B; int lda, ldb, nM, nN, nt, G, c, pm0;
    __device__ __forceinline__ bool next(int i, Unit& u) const {
        int pm, pn; if (!pg8::tile_of(i * G + c, nM, nN, pm, pn)) return false;
        u.A = A + (size_t)pm * 256 * lda; u.B = B + (size_t)pn * 256 * ldb; u.nt = nt; u.pm = pm0 + pm; u.pn = pn; u.mode = 0; return true;
    }
};
struct SchedS5 {
    const bf16_t* UC; const bf16_t* B; int ldb, nN, nt, G, c, nmt;
    __device__ __forceinline__ bool next(int i, Unit& u) const {
        const int L = i * G + c; if (L >= 32 * nmt * nN) return false;
        const int pn = L % nN, mt = (L / nN) % nmt, g = L / (nmt * nN);
        u.A = UC + ((size_t)g * CHPAD + 256 * mt) * 768; u.B = B + ((size_t)g * nN * 256 + (size_t)pn * 256) * ldb; u.nt = nt; u.pm = mt; u.pn = pn; u.mode = g; return true;
    }
};
struct SchedMerge {
    const bf16_t* H; const bf16_t* YAB; const bf16_t* YD; const bf16_t* Bcat; int nchain, G, c;
    __device__ __forceinline__ bool next(int i, Unit& u) const {
        const int nl = (c < 512) ? (512 - c + G - 1) / G : 0;
        int pm, pn, j, sub;
        if (i < 6 * nl) { const int ti = i / 6; sub = i - ti * 6; j = sub >> 1; pg8::tile_of(ti * G + c, 128, 4, pm, pn); u.mode = sub; }
        else { const int k = i - 6 * nl; if (k >= 2 || c >= nchain) return false;
               const int tile = c / 3; j = c - tile * 3; pm = 128 + (tile >> 2); pn = tile & 3; sub = k; u.mode = 8 + 2 * j + k; }
        const bf16_t* Bj = Bcat + (size_t)j * 1024 * 1536 + (size_t)pn * 256 * 1536;
        if ((sub & 1) == 0) { u.A = H + (size_t)pm * 256 * 1024; u.B = Bj; u.nt = 16; }
        else { const bf16_t* Y = (j == 0) ? YAB : (j == 1) ? (YAB + 512) : YD; u.A = Y + (size_t)pm * 256 * 1024; u.B = Bj + 1024; u.nt = 8; }
        u.pm = pm; u.pn = pn; return true;
    }
};
struct SchedG4 {
    const bf16_t* M; const bf16_t* MCTX; const bf16_t* B; int nchain, G, c;
    __device__ __forceinline__ bool next(int i, Unit& u) const {
        const int L = i * G + c;
        if (L < 512) { int pm, pn; pg8::tile_of(L, 128, 4, pm, pn); u.A = M + (size_t)pm * 256 * 1024; u.B = B + (size_t)pn * 256 * 1024; u.nt = 16; u.pm = pm; u.pn = pn; u.mode = 0; return true; }
        const int p = L - 512; if (p >= nchain) return false;
        const int tile = p / 3, j = p - tile * 3, pm = 128 + (tile >> 2), pn = tile & 3;
        u.A = MCTX + (size_t)j * NCTX * 1024 + (size_t)(pm - 128) * 256 * 1024; u.B = B + (size_t)pn * 256 * 1024; u.nt = 16; u.pm = pm; u.pn = pn; u.mode = 1 + j; return true;
    }
};
struct SchedG6c {
    const bf16_t* A; const bf16_t* B; int G, c, nparts;
    __device__ __forceinline__ bool next(int i, Unit& u) const {
        const int L = i * G + c;
        if (L < 512) { int pm, pn; pg8::tile_of(L, 128, 4, pm, pn); u.A = A + (size_t)pm * 256 * 2816; u.B = B + (size_t)pn * 256 * 2816; u.nt = 44; u.pm = pm; u.pn = pn; u.mode = 0; return true; }
        if (L >= 512 + nparts) return false;
        const int p = L - 512, tile = p >> 2, kp = p & 3, pm = 128 + (tile >> 2), pn = tile & 3, koff = (kp < 2) ? kp * 768 : 1536 + (kp - 2) * 640;
        u.A = A + (size_t)pm * 256 * 2816 + koff; u.B = B + (size_t)pn * 256 * 2816 + koff; u.nt = (kp < 2) ? 12 : 10; u.pm = pm; u.pn = pn; u.mode = 1 + kp; return true;
    }
};

#define FOR_AI_M _Pragma("unroll") for (int ai = 0; ai < 2; ++ai) _Pragma("unroll") for (int m = 0; m < 4; ++m)

struct EpiG1 {
    bf16_t *YAB, *YD, *KA, *VA, *KC, *VC, *UC; const float* qkg; const float* tab;
    __device__ __forceinline__ void operator()(const f32x4 (&acc)[2][2][4][2], const Unit& u, int wr, int wc, int fr, int fq) const {
        const int pn = u.pn; const bool isctx = u.pm >= 128;
        int kind; bf16_t* dst = nullptr; int pitch = 0, colbase = 0; const float* gain = qkg;
        if (pn < 2) { kind = 0; dst = YAB; pitch = 1024; colbase = 256 * pn + 64 * wc; gain = qkg; }
        else if (pn == 2) { if (wc < 2) { kind = 1; dst = KA; pitch = 128; colbase = 64 * wc; gain = qkg + 64; } else { kind = 2; dst = VA; pitch = 128; colbase = 64 * (wc - 2); } }
        else if (pn < 5) { kind = 3; }
        else if (pn < 7) { kind = 0; dst = YD; pitch = 1024; colbase = 256 * (pn - 5) + 64 * wc; gain = qkg + 128; }
        else if (pn < 9) { kind = 1; dst = KC; pitch = 512; colbase = 256 * (pn - 7) + 64 * wc; gain = qkg + 192; }
        else { kind = 2; dst = VC; pitch = 512; colbase = 256 * (pn - 9) + 64 * wc; }
        if (kind <= 1) {
            f32x4 g[2][2];
#pragma unroll
            for (int bj = 0; bj < 2; ++bj)
#pragma unroll
                for (int n = 0; n < 2; ++n) g[bj][n] = *(const f32x4*)(gain + 32 * bj + 8 * fq + 4 * n);
            const float qs = (kind == 0) ? QSCALE : 1.0f;
            FOR_AI_M {
                const int row = 256 * u.pm + 128 * ai + 64 * wr + 16 * m + fr;
                f32x4 x[2][2]; float ss = 0.f;
#pragma unroll
                for (int bj = 0; bj < 2; ++bj)
#pragma unroll
                    for (int n = 0; n < 2; ++n) { x[bj][n] = acc[ai][bj][m][n]; ss += (x[bj][n][0] * x[bj][n][0] + x[bj][n][1] * x[bj][n][1]) + (x[bj][n][2] * x[bj][n][2] + x[bj][n][3] * x[bj][n][3]); }
                ss += shx<16>(ss); ss = sum_x32(ss);
                const float rinv = rsqrtf(ss * (1.0f / 64.0f) + EPS);
#pragma unroll
                for (int bj = 0; bj < 2; ++bj)
#pragma unroll
                    for (int n = 0; n < 2; ++n) x[bj][n] = x[bj][n] * rinv * g[bj][n];
                if (!isctx) {
                    const int t = row & (SEQ - 1); const int p = (fq < 2) ? (t >> 6) : (t & 63);
                    const float* tp = tab + (p * 16 + 8 * (fq & 1)) * 2;
#pragma unroll
                    for (int n = 0; n < 2; ++n) {
                        const f32x4 cs0 = *(const f32x4*)(tp + 8 * n), cs1 = *(const f32x4*)(tp + 8 * n + 4);
                        const float c[4] = {cs0[0], cs0[2], cs1[0], cs1[2]}, s[4] = {cs0[1], cs0[3], cs1[1], cs1[3]};
#pragma unroll
                        for (int e = 0; e < 4; ++e) { const float lo = x[0][n][e], hi = x[1][n][e]; x[0][n][e] = lo * c[e] - hi * s[e]; x[1][n][e] = hi * c[e] + lo * s[e]; }
                    }
                }
#pragma unroll
                for (int bj = 0; bj < 2; ++bj) {
                    u32x4 w; w.x = cvt_pk_bf16(x[bj][0][0] * qs, x[bj][0][1] * qs); w.y = cvt_pk_bf16(x[bj][0][2] * qs, x[bj][0][3] * qs);
                    w.z = cvt_pk_bf16(x[bj][1][0] * qs, x[bj][1][1] * qs); w.w = cvt_pk_bf16(x[bj][1][2] * qs, x[bj][1][3] * qs);
                    *(u32x4*)(dst + (size_t)row * pitch + colbase + 32 * bj + 8 * fq) = w;
                }
            }
        } else if (kind == 2) {
            FOR_AI_M {
                const int row = 256 * u.pm + 128 * ai + 64 * wr + 16 * m + fr;
#pragma unroll
                for (int bj = 0; bj < 2; ++bj) {
                    const f32x4 a = acc[ai][bj][m][0], b = acc[ai][bj][m][1];
                    u32x4 w; w.x = cvt_pk_bf16(a[0], a[1]); w.y = cvt_pk_bf16(a[2], a[3]); w.z = cvt_pk_bf16(b[0], b[1]); w.w = cvt_pk_bf16(b[2], b[3]);
                    *(u32x4*)(dst + (size_t)row * pitch + colbase + 32 * bj + 8 * fq) = w;
                }
            }
        } else {
            FOR_AI_M {
                const int row = 256 * u.pm + 128 * ai + 64 * wr + 16 * m + fr;
#pragma unroll
                for (int bj = 0; bj < 2; ++bj) {
                    const int g = 16 * (pn - 3) + 4 * wc + 2 * bj + (fq >> 1);
                    const f32x4 a = acc[ai][bj][m][0], b = acc[ai][bj][m][1];
                    u32x4 w; w.x = cvt_pk_bf16(a[0], a[1]); w.y = cvt_pk_bf16(a[2], a[3]); w.z = cvt_pk_bf16(b[0], b[1]); w.w = cvt_pk_bf16(b[2], b[3]);
                    *(u32x4*)(UC + ((size_t)g * CHPAD + (row >> 5)) * 768 + (row & 31) * 16 + 8 * (fq & 1)) = w;
                }
            }
        }
    }
};

struct EpiS {
    float* S;
    __device__ __forceinline__ void operator()(const f32x4 (&acc)[2][2][4][2], const Unit& u, int wr, int wc, int fr, int fq) const {
        FOR_AI_M {
            const int chunk = 256 * u.pm + 128 * ai + 64 * wr + 16 * m + fr;
            float* rp = S + ((size_t)u.mode * CHPAD + chunk) * 256 + 32 * wc + 4 * fq;
#pragma unroll
            for (int bj = 0; bj < 2; ++bj)
#pragma unroll
                for (int n = 0; n < 2; ++n) *(f32x4*)(rp + 128 * bj + 16 * n) = acc[ai][bj][m][n];
        }
    }
};

struct EpiY {
    bf16_t* GACT;
    __device__ __forceinline__ void operator()(const f32x4 (&acc)[2][2][4][2], const Unit& u, int wr, int wc, int fr, int fq) const {
        FOR_AI_M {
            const int chunk = 256 * u.pm + 128 * ai + 64 * wr + 16 * m + fr;
            if (chunk < NCHUNK) {
#pragma unroll
                for (int bj = 0; bj < 2; ++bj)
#pragma unroll
                    for (int n = 0; n < 2; ++n) {
                        const int tl = 16 * u.pn + 8 * bj + 2 * wc + n; const size_t row = (size_t)chunk * 32 + tl;
                        const f32x4 v = acc[ai][bj][m][n];
                        u32x2 w; w.x = cvt_pk_bf16(gelu_tanh(v[0]), gelu_tanh(v[1])); w.y = cvt_pk_bf16(gelu_tanh(v[2]), gelu_tanh(v[3]));
                        *(u32x2*)(GACT + row * 1024 + 16 * u.mode + 4 * fq) = w;
                    }
            }
        }
    }
};

struct EpiGLU {
    const bf16_t* GACT; bf16_t* YB; const float* bglu;
    __device__ __forceinline__ void operator()(const f32x4 (&acc)[2][2][4][2], const Unit& u, int wr, int wc, int fr, int fq) const {
        f32x4 bv[2][2];
#pragma unroll
        for (int bj = 0; bj < 2; ++bj)
#pragma unroll
            for (int n = 0; n < 2; ++n) bv[bj][n] = *(const f32x4*)(bglu + 256 * u.pn + 128 * bj + 32 * wc + 8 * fq + 4 * n);
        const size_t col0 = (size_t)256 * u.pn + 32 * wc + 8 * fq;
        u32x4 gpre[2][2];
#pragma unroll
        for (int bj = 0; bj < 2; ++bj) gpre[0][bj] = *(const u32x4*)(GACT + ((size_t)256 * u.pm + 64 * wr + fr) * 1024 + col0 + 128 * bj);
#pragma unroll
        for (int g = 0; g < 8; ++g) {
            const int ai = g >> 2, m = g & 3;
            const size_t row = (size_t)256 * u.pm + 128 * ai + 64 * wr + 16 * m + fr;
            if (g + 1 < 8) {
                const size_t rn = (size_t)256 * u.pm + 128 * ((g + 1) >> 2) + 64 * wr + 16 * ((g + 1) & 3) + fr;
#pragma unroll
                for (int bj = 0; bj < 2; ++bj) gpre[(g + 1) & 1][bj] = *(const u32x4*)(GACT + rn * 1024 + col0 + 128 * bj);
            }
            asm volatile("" ::: "memory");
#pragma unroll
            for (int bj = 0; bj < 2; ++bj) {
                const u32x4 gv = gpre[g & 1][bj];
                const f32x4 a = acc[ai][bj][m][0] + bv[bj][0], b = acc[ai][bj][m][1] + bv[bj][1];
                u32x4 w;
                w.x = cvt_pk_bf16(bflo(gv.x) * sigmoidf_(a[0]), bfhi(gv.x) * sigmoidf_(a[1])); w.y = cvt_pk_bf16(bflo(gv.y) * sigmoidf_(a[2]), bfhi(gv.y) * sigmoidf_(a[3]));
                w.z = cvt_pk_bf16(bflo(gv.z) * sigmoidf_(b[0]), bfhi(gv.z) * sigmoidf_(b[1])); w.w = cvt_pk_bf16(bflo(gv.w) * sigmoidf_(b[2]), bfhi(gv.w) * sigmoidf_(b[3]));
                *(u32x4*)(YB + row * 1024 + col0 + 128 * bj) = w;
            }
        }
    }
};

struct EpiMerge {
    bf16_t* M; float* stm; unsigned* stg; int tid_; bf16_t* MCTX;
    __device__ __forceinline__ void operator()(const f32x4 (&acc)[2][2][4][2], const Unit& u, int wr, int wc, int fr, int fq) const {
        const int sub = u.mode, tid = (wr * 4 + wc) * 64 + fq * 16 + fr;
        if ((sub & 1) == 0) {
            FOR_AI_M {
#pragma unroll
                for (int bj = 0; bj < 2; ++bj) {
                    const int i0 = (((ai * 2 + bj) * 4 + m) * 2) * 512 + tid, i1 = i0 + 512;
                    const f32x4 a = acc[ai][bj][m][0], b = acc[ai][bj][m][1];
                    u32x2 w0, w1; w0.x = cvt_pk_bf16(sigmoidf_(a[0]), sigmoidf_(a[1])); w0.y = cvt_pk_bf16(sigmoidf_(a[2]), sigmoidf_(a[3]));
                    w1.x = cvt_pk_bf16(sigmoidf_(b[0]), sigmoidf_(b[1])); w1.y = cvt_pk_bf16(sigmoidf_(b[2]), sigmoidf_(b[3]));
                    *(u32x2*)(stg + (size_t)i0 * 2) = w0; *(u32x2*)(stg + (size_t)i1 * 2) = w1;
                }
                asm volatile("" ::: "memory");
            }
            return;
        }
        const bool iso = sub >= 8, addm = (sub > 1) && !iso;
        u32x2 gp[2][2][2]; f32x4 mp[2][2][2];
#pragma unroll
        for (int bj = 0; bj < 2; ++bj) {
            const int i0 = ((bj * 4) * 2) * 512 + tid, i1 = i0 + 512;
            gp[0][bj][0] = *(const u32x2*)(stg + (size_t)i0 * 2); gp[0][bj][1] = *(const u32x2*)(stg + (size_t)i1 * 2);
            if (addm) { mp[0][bj][0] = *(const f32x4*)(stm + (size_t)i0 * 4); mp[0][bj][1] = *(const f32x4*)(stm + (size_t)i1 * 4); }
        }
#pragma unroll
        for (int g = 0; g < 8; ++g) {
            const int ai = g >> 2, m = g & 3;
            const size_t row = (size_t)256 * u.pm + 128 * ai + 64 * wr + 16 * m + fr;
            if (g + 1 < 8) {
                const int an = (g + 1) >> 2, mn = (g + 1) & 3;
#pragma unroll
                for (int bj = 0; bj < 2; ++bj) {
                    const int i0 = (((an * 2 + bj) * 4 + mn) * 2) * 512 + tid, i1 = i0 + 512;
                    gp[(g + 1) & 1][bj][0] = *(const u32x2*)(stg + (size_t)i0 * 2); gp[(g + 1) & 1][bj][1] = *(const u32x2*)(stg + (size_t)i1 * 2);
                    if (addm) { mp[(g + 1) & 1][bj][0] = *(const f32x4*)(stm + (size_t)i0 * 4); mp[(g + 1) & 1][bj][1] = *(const f32x4*)(stm + (size_t)i1 * 4); }
                }
            }
            asm volatile("" ::: "memory");
#pragma unroll
            for (int bj = 0; bj < 2; ++bj) {
                const int i0 = (((ai * 2 + bj) * 4 + m) * 2) * 512 + tid, i1 = i0 + 512;
                const u32x2 g0 = gp[g & 1][bj][0], g1 = gp[g & 1][bj][1];
                f32x4 a = acc[ai][bj][m][0], b = acc[ai][bj][m][1];
                a = a * (f32x4){bflo(g0.x), bfhi(g0.x), bflo(g0.y), bfhi(g0.y)}; b = b * (f32x4){bflo(g1.x), bfhi(g1.x), bflo(g1.y), bfhi(g1.y)};
                if (addm) { a += mp[g & 1][bj][0]; b += mp[g & 1][bj][1]; }
                if (sub < 5) { *(f32x4*)(stm + (size_t)i0 * 4) = a; *(f32x4*)(stm + (size_t)i1 * 4) = b; }
                else {
                    u32x4 w; w.x = cvt_pk_bf16(a[0], a[1]); w.y = cvt_pk_bf16(a[2], a[3]); w.z = cvt_pk_bf16(b[0], b[1]); w.w = cvt_pk_bf16(b[2], b[3]);
                    bf16_t* dst = iso ? MCTX + (size_t)((sub - 8) >> 1) * NCTX * 1024 + (row - NLAT) * 1024 : M + row * 1024;
                    *(u32x4*)(dst + 256 * u.pn + 128 * bj + 32 * wc + 8 * fq) = w;
                }
            }
        }
    }
};

struct EpiRes {
    const float* base_lat; const float* base_ctx; float* out_lat; float* out_ctx; const float* mod; int moff; float* part;
    __device__ __forceinline__ void operator()(const f32x4 (&acc)[2][2][4][2], const Unit& u, int wr, int wc, int fr, int fq) const {
        const int row0 = 256 * u.pm; const bool isctx = row0 >= NLAT; const int mb = isctx ? 4 : (row0 >> 13);
        const float* bp = isctx ? base_ctx + (size_t)(row0 - NLAT) * 1024 : base_lat + (size_t)row0 * 1024;
        float* op = isctx ? out_ctx + (size_t)(row0 - NLAT) * 1024 : out_lat + (size_t)row0 * 1024;
        const float* mp = mod + mb * 6144 + moff;
        f32x4 mv[2][2];
#pragma unroll
        for (int bj = 0; bj < 2; ++bj)
#pragma unroll
            for (int n = 0; n < 2; ++n) mv[bj][n] = *(const f32x4*)(mp + 256 * u.pn + 128 * bj + 32 * wc + 8 * fq + 4 * n);
        const size_t cb0 = (size_t)256 * u.pn + 32 * wc + 8 * fq;
        if (u.mode > 0) {
            float* pp = part + (size_t)(u.mode - 1) * NCTX * 1024 + (size_t)(row0 - NLAT) * 1024;
            FOR_AI_M {
                const size_t ro = (size_t)(128 * ai + 64 * wr + 16 * m + fr) * 1024 + cb0;
#pragma unroll
                for (int bj = 0; bj < 2; ++bj)
#pragma unroll
                    for (int n = 0; n < 2; ++n) *(f32x4*)(pp + ro + 128 * bj + 4 * n) = mv[bj][n] * acc[ai][bj][m][n];
            }
            return;
        }
        f32x4 pre[2][2][2];
#pragma unroll
        for (int bj = 0; bj < 2; ++bj)
#pragma unroll
            for (int n = 0; n < 2; ++n) pre[0][bj][n] = *(const f32x4*)(bp + (size_t)(64 * wr + fr) * 1024 + cb0 + 128 * bj + 4 * n);
#pragma unroll
        for (int g = 0; g < 8; ++g) {
            const int ai = g >> 2, m = g & 3;
            const size_t ro = (size_t)(128 * ai + 64 * wr + 16 * m + fr) * 1024 + cb0;
            if (g + 1 < 8) {
                const size_t rn = (size_t)(128 * ((g + 1) >> 2) + 64 * wr + 16 * ((g + 1) & 3) + fr) * 1024 + cb0;
#pragma unroll
                for (int bj = 0; bj < 2; ++bj)
#pragma unroll
                    for (int n = 0; n < 2; ++n) pre[(g + 1) & 1][bj][n] = *(const f32x4*)(bp + rn + 128 * bj + 4 * n);
            }
            asm volatile("" ::: "memory");
#pragma unroll
            for (int bj = 0; bj < 2; ++bj)
#pragma unroll
                for (int n = 0; n < 2; ++n) *(f32x4*)(op + ro + 128 * bj + 4 * n) = pre[g & 1][bj][n] + mv[bj][n] * acc[ai][bj][m][n];
        }
    }
};

__device__ __forceinline__ float dpp_shr1(float v) { return __builtin_bit_cast(float, __builtin_amdgcn_update_dpp(0, __builtin_bit_cast(int, v), 0x111, 0xf, 0xf, true)); }
__device__ __forceinline__ float dpp_shl1(float v) { return __builtin_bit_cast(float, __builtin_amdgcn_update_dpp(0, __builtin_bit_cast(int, v), 0x101, 0xf, 0xf, true)); }

struct SchedUp {
    const bf16_t* H; const bf16_t* HB; const bf16_t* B; int nM, G, c;
    __device__ __forceinline__ bool next(int i, Unit& u) const {
        const int L = i * G + c, nmain = nM * 22;
        if (L < nmain) { int pm, pn; pg8::tile_of(L, nM, 22, pm, pn); u.A = H + (size_t)pm * 256 * 1024; u.B = B + (size_t)pn * 256 * 1024; u.nt = 16; u.pm = pm; u.pn = pn; u.mode = 0; return true; }
        const int Lb = L - nmain; if (Lb >= 110) return false;
        const int mt = Lb / 22, pn = Lb - mt * 22;
        u.A = HB + (size_t)mt * 256 * 1024; u.B = B + (size_t)pn * 256 * 1024; u.nt = 16; u.pm = mt; u.pn = pn; u.mode = 1; return true;
    }
};

struct EpiUpConv {
    bf16_t* ACT; int nrows; const float* cw; const float* cb;
    __device__ __forceinline__ void operator()(const f32x4 (&acc)[2][2][4][2], const Unit& u, int wr, int wc, int fr, int fq) const {
        if (u.mode == 1) {
#pragma unroll
            for (int n = 0; n < 2; ++n) {
                const int f0 = 128 * u.pn + 32 * wc + 8 * fq + 4 * n;
                f32x4 wa[3], wg[3];
#pragma unroll
                for (int j = 0; j < 3; ++j) { wa[j] = *(const f32x4*)(cw + j * 5632 + f0); wg[j] = *(const f32x4*)(cw + j * 5632 + 2816 + f0); }
                const f32x4 ba = *(const f32x4*)(cb + f0), bg = *(const f32x4*)(cb + 2816 + f0);
#pragma unroll
                for (int ai = 0; ai < 2; ++ai) {
                    const int j = 64 * u.pm + 32 * wr + 2 * fr + ai;
                    const bool seqb = (j < 256) ? ((j & 63) == 0) : ((j & 1) == 0);
                    const f32x4 z4 = (f32x4){0.f, 0.f, 0.f, 0.f};
                    const int rowL = 128 * j - 1, rowR = 128 * j;
                    if (j >= 1 && j < NBGRP && rowL < nrows) {
                        const f32x4 ca = wa[0] * acc[ai][0][0][n] + wa[1] * acc[ai][0][1][n] + wa[2] * (seqb ? z4 : acc[ai][0][2][n]) + ba;
                        const f32x4 cg = wg[0] * acc[ai][1][0][n] + wg[1] * acc[ai][1][1][n] + wg[2] * (seqb ? z4 : acc[ai][1][2][n]) + bg;
                        u32x2 w; w.x = cvt_pk_bf16(cg[0] * sigmoidf_(cg[0]) * ca[0], cg[1] * sigmoidf_(cg[1]) * ca[1]); w.y = cvt_pk_bf16(cg[2] * sigmoidf_(cg[2]) * ca[2], cg[3] * sigmoidf_(cg[3]) * ca[3]);
                        *(u32x2*)(ACT + (size_t)rowL * 2816 + f0) = w;
                    }
                    if (j < NBGRP && rowR < nrows) {
                        const f32x4 ca = wa[0] * (seqb ? z4 : acc[ai][0][1][n]) + wa[1] * acc[ai][0][2][n] + wa[2] * acc[ai][0][3][n] + ba;
                        const f32x4 cg = wg[0] * (seqb ? z4 : acc[ai][1][1][n]) + wg[1] * acc[ai][1][2][n] + wg[2] * acc[ai][1][3][n] + bg;
                        u32x2 w; w.x = cvt_pk_bf16(cg[0] * sigmoidf_(cg[0]) * ca[0], cg[1] * sigmoidf_(cg[1]) * ca[1]); w.y = cvt_pk_bf16(cg[2] * sigmoidf_(cg[2]) * ca[2], cg[3] * sigmoidf_(cg[3]) * ca[3]);
                        *(u32x2*)(ACT + (size_t)rowR * 2816 + f0) = w;
                    }
                }
            }
            return;
        }
        const size_t row0 = (size_t)256 * u.pm + 128 * wr + 8 * fr;
#pragma unroll
        for (int n = 0; n < 2; ++n) {
            const int f0 = 128 * u.pn + 32 * wc + 8 * fq + 4 * n;
            f32x4 wa[3], wg[3];
#pragma unroll
            for (int j = 0; j < 3; ++j) { wa[j] = *(const f32x4*)(cw + j * 5632 + f0); wg[j] = *(const f32x4*)(cw + j * 5632 + 2816 + f0); }
            const f32x4 ba = *(const f32x4*)(cb + f0), bg = *(const f32x4*)(cb + 2816 + f0);
            f32x4 pa, pg, na, ng;
#pragma unroll
            for (int e = 0; e < 4; ++e) { pa[e] = dpp_shr1(acc[1][0][3][n][e]); pg[e] = dpp_shr1(acc[1][1][3][n][e]); na[e] = dpp_shl1(acc[0][0][0][n][e]); ng[e] = dpp_shl1(acc[0][1][0][n][e]); }
#pragma unroll
            for (int k = 0; k < 8; ++k) {
                const f32x4 ua0 = (k == 0) ? pa : acc[(k - 1) >> 2][0][(k - 1) & 3][n], ua1 = acc[k >> 2][0][k & 3][n], ua2 = (k == 7) ? na : acc[(k + 1) >> 2][0][(k + 1) & 3][n];
                const f32x4 ug0 = (k == 0) ? pg : acc[(k - 1) >> 2][1][(k - 1) & 3][n], ug1 = acc[k >> 2][1][k & 3][n], ug2 = (k == 7) ? ng : acc[(k + 1) >> 2][1][(k + 1) & 3][n];
                const f32x4 ca = wa[0] * ua0 + wa[1] * ua1 + wa[2] * ua2 + ba, cg = wg[0] * ug0 + wg[1] * ug1 + wg[2] * ug2 + bg;
                u32x2 w; w.x = cvt_pk_bf16(cg[0] * sigmoidf_(cg[0]) * ca[0], cg[1] * sigmoidf_(cg[1]) * ca[1]); w.y = cvt_pk_bf16(cg[2] * sigmoidf_(cg[2]) * ca[2], cg[3] * sigmoidf_(cg[3]) * ca[3]);
                const bool edge = (k == 0 && fr == 0) || (k == 7 && fr == 15);
                if (!edge) *(u32x2*)(ACT + (row0 + k) * 2816 + f0) = w;
            }
        }
    }
};

#define XB_TMO      128
#define XB_XCNT(j)  (256  + 64 * (j))
#define XB_XSUB(j)  (1280 + 64 * (j))
#define XB_XGEN(j)  (2304 + 64 * (j))
#define XB_TOP      3328
#define XB_TOPGEN   3392
#define XCD_BAR_WORDS 3456
#define XB_SPIN_CAP (1u << 22)
__device__ __forceinline__ unsigned xb_ld(unsigned* p)              { return __hip_atomic_load(p, __ATOMIC_RELAXED, __HIP_MEMORY_SCOPE_AGENT); }
__device__ __forceinline__ unsigned xb_add(unsigned* p, unsigned v) { return __hip_atomic_fetch_add(p, v, __ATOMIC_RELAXED, __HIP_MEMORY_SCOPE_AGENT); }
__device__ __forceinline__ unsigned xb_xcc_id() { return (unsigned)__builtin_amdgcn_s_getreg((3 << 11) | 20) & 0xFu; }
#define XB_SPIN(cond, bar) do { unsigned _sp = 0; while (cond) { __builtin_amdgcn_s_sleep(1); \
    if ((++_sp & 255u) == 0u) { if (xb_ld(&(bar)[XB_TMO])) break; if (_sp > XB_SPIN_CAP) { atomicAdd(&(bar)[XB_TMO], 1u); break; } } } } while (0)
struct XcdBarrier { unsigned* bar; unsigned x; volatile LAS unsigned* st; };
__device__ __forceinline__ XcdBarrier xcd_barrier_post(unsigned* bar, volatile LAS unsigned* st) {
    XcdBarrier b; b.bar = bar; b.x = xb_xcc_id(); b.st = st;
    if (threadIdx.x == 0) (void)xb_add(&bar[XB_XCNT(b.x)], 1u);
    return b;
}
__device__ __forceinline__ void xcd_barrier_complete(unsigned* bar, unsigned x, unsigned& nloc, unsigned& nx) {
    const unsigned G = gridDim.x * gridDim.y * gridDim.z;
    unsigned sum, cnt, mine, sp = 0u;
    for (;;) {
        sum = 0u; cnt = 0u; mine = 0u;
#pragma unroll
        for (unsigned j = 0; j < 16; ++j) { const unsigned c = xb_ld(&bar[XB_XCNT(j)]); sum += c; cnt += (c > 0u) ? 1u : 0u; mine = (j == x) ? c : mine; }
        if (sum == G) break;
        __builtin_amdgcn_s_sleep(1);
        if ((++sp & 255u) == 0u) { if (xb_ld(&bar[XB_TMO])) break; if (sp > XB_SPIN_CAP) { atomicAdd(&bar[XB_TMO], 1u); break; } }
    }
    nloc = mine > 0u ? mine : 1u; nx = cnt > 0u ? cnt : 1u;
}
__device__ __forceinline__ void xcd_barrier(const XcdBarrier& b) {
    asm volatile("s_waitcnt vmcnt(0)" ::: "memory");
    __syncthreads();
    if (threadIdx.x == 0) {
        unsigned* bar = b.bar;
        __builtin_amdgcn_s_waitcnt(0);
        unsigned nloc = b.st[0], nx = b.st[1];
        if (nloc == 0u) { xcd_barrier_complete(bar, b.x, nloc, nx); b.st[0] = nloc; b.st[1] = nx; }
        const unsigned old = xb_add(&bar[XB_XSUB(b.x)], 1u);
        const unsigned gen = old / nloc;
        if (old + 1u == (gen + 1u) * nloc) {
            __builtin_amdgcn_fence(__ATOMIC_RELEASE, "agent");
            asm volatile("s_waitcnt vmcnt(0)" ::: "memory");
            const unsigned og = xb_add(&bar[XB_TOP], 1u);
            const unsigned tg = og / nx;
            if (og + 1u == (tg + 1u) * nx) xb_add(&bar[XB_TOPGEN], 1u);
            else XB_SPIN(xb_ld(&bar[XB_TOPGEN]) == tg, bar);
            __builtin_amdgcn_fence(__ATOMIC_ACQUIRE, "agent");
            xb_add(&bar[XB_XGEN(b.x)], 1u);
            asm volatile("s_waitcnt vmcnt(0)" ::: "memory");
        } else {
            XB_SPIN(xb_ld(&bar[XB_XGEN(b.x)]) == gen, bar);
            __builtin_amdgcn_fence(__ATOMIC_ACQUIRE, "agent");
            asm volatile("s_waitcnt vmcnt(0)" ::: "memory");
        }
    }
    __syncthreads();
}

struct Frame {
    unsigned char* lds; int tid, lane, wave, G, bid;
};

__device__ __forceinline__ void transpose_item(const float* W, int ldw, int k0, int n0, bf16_t* WT, int ldt, int drow0, int kdst0, float* scr, int lane) {
#pragma unroll 8
    for (int i = 0; i < 32; ++i) { const int kk = 2 * i + (lane >> 5); scr[kk * 33 + (lane & 31)] = W[(size_t)(k0 + kk) * ldw + n0 + (lane & 31)]; }
    asm volatile("s_waitcnt lgkmcnt(0)" ::: "memory");
    const int c = lane & 7;
#pragma unroll
    for (int j = 0; j < 4; ++j) {
        const int n = (lane >> 3) + 8 * j; const float* s = scr + (8 * c) * 33 + n;
        u32x4 o; o.x = cvt_pk_bf16(s[0 * 33], s[1 * 33]); o.y = cvt_pk_bf16(s[2 * 33], s[3 * 33]); o.z = cvt_pk_bf16(s[4 * 33], s[5 * 33]); o.w = cvt_pk_bf16(s[6 * 33], s[7 * 33]);
        const int di = 16 * ((n >> 2) & 1) + 4 * (n >> 3) + (n & 3);
        *(u32x4*)(WT + (size_t)(drow0 + di) * ldt + kdst0 + k0 + 8 * c) = o;
    }
    asm volatile("s_waitcnt lgkmcnt(0)" ::: "memory");
}

__device__ __forceinline__ void prep_weights(const Frame& F, const Params& P, int l) {
    float* scr = (float*)(F.lds + F.wave * 16384);
    bf16_t* Wb = (bf16_t*)(P.ws + WS_W);
    const float* w_in = P.in[7] + (size_t)l * 1024 * NIN; const float* w_glu = P.in[17] + (size_t)l * 512 * 512; const float* w_br = P.in[21] + (size_t)l * 3 * 512 * 1024;
    const float* w_out = P.in[22] + (size_t)l * 1024 * 1024; const float* w_up = P.in[23] + (size_t)l * 1024 * 5632; const float* w_down = P.in[26] + (size_t)l * 2816 * 1024;
    constexpr int I1 = 16 * 88, I2 = 3 * 16 * 32, I3 = 3 * 8 * 32, I4 = 8 * 16, I5 = 16 * 32, I6 = 16 * 176, I7 = 44 * 32;
    constexpr int NIT = I1 + I2 + I3 + I4 + I5 + I6 + I7;
    const int gw = F.bid * 8 + F.wave, NGW = F.G * 8;
    for (int it = gw; it < NIT; it += NGW) {
        int r = it;
        if (r < I1) { const int kb = r / 88, dg = r % 88, pn = dg >> 3, bj = (dg >> 2) & 1, wc = dg & 3;
            transpose_item(w_in, NIN, 64 * kb, 256 * pn + 64 * wc + 32 * bj, (bf16_t*)((unsigned char*)Wb + W_WIN), 1024, 32 * dg, 0, scr, F.lane); continue; } r -= I1;
        if (r < I2) { const int j = r / 512, rr = r % 512, kb = rr / 32, dg = rr % 32;
            transpose_item(w_in, NIN, 64 * kb, 2816 + 1024 * j + 32 * dg, (bf16_t*)((unsigned char*)Wb + W_BCAT) + (size_t)j * 1024 * 1536, 1536, 32 * dg, 0, scr, F.lane); continue; } r -= I2;
        if (r < I3) { const int j = r / 256, rr = r % 256, kb = rr / 32, dg = rr % 32;
            transpose_item(w_br + (size_t)j * 512 * 1024, 1024, 64 * kb, 32 * dg, (bf16_t*)((unsigned char*)Wb + W_BCAT) + (size_t)j * 1024 * 1536, 1536, 32 * dg, 1024, scr, F.lane); continue; } r -= I3;
        if (r < I4) { const int kb = r / 16, dg = r % 16;
            transpose_item(w_glu, 512, 64 * kb, 32 * dg, (bf16_t*)((unsigned char*)Wb + W_GLU), 512, 32 * dg, 0, scr, F.lane); continue; } r -= I4;
        if (r < I5) { const int kb = r / 32, dg = r % 32;
            transpose_item(w_out, 1024, 64 * kb, 32 * dg, (bf16_t*)((unsigned char*)Wb + W_OUT), 1024, 32 * dg, 0, scr, F.lane); continue; } r -= I5;
        if (r < I6) { const int kb = r / 176, dg = r % 176, pn = dg >> 3, bj = (dg >> 2) & 1, wc = dg & 3;
            transpose_item(w_up, 5632, 64 * kb, bj * 2816 + 128 * pn + 32 * wc, (bf16_t*)((unsigned char*)Wb + W_UP), 1024, 32 * dg, 0, scr, F.lane); continue; } r -= I6;
        { const int kb = r / 32, dg = r % 32;
            transpose_item(w_down, 1024, 64 * kb, 32 * dg, (bf16_t*)((unsigned char*)Wb + W_DOWN), 2816, 32 * dg, 0, scr, F.lane); }
    }
}

__device__ __forceinline__ void prep_s5_part(const Frame& F, const Params& P, int l, int g, int c) {
    float* apr = (float*)F.lds;
    float* api = apr + 2 * 33 * 64;
    float* bbr = api + 2 * 33 * 64;
    float* bbi = bbr + 2 * 64 * 16;
    float* ccr = bbi + 2 * 64 * 16;
    float* cci = ccr + 2 * 64;
    float* Kt = cci + 2 * 64;
    const float* lam_re = P.in[9]; const float* lam_im = P.in[10]; const float* log_dt = P.in[11];
    const float* b_re = P.in[12]; const float* b_im = P.in[13]; const float* c_re = P.in[14]; const float* c_im = P.in[15]; const float* dsk = P.in[16] + l * 512 + g * 16;
    __syncthreads();
    for (int idx = F.tid; idx < 2 * 33 * 64; idx += 512) {
        const int d = idx / (33 * 64), e = (idx / 64) % 33, p = idx % 64; const int gi = (l * 2 + d) * 32 + g;
        const float lr = lam_re[gi * 64 + p], li = lam_im[gi * 64 + p], dt = expf(log_dt[gi]);
        const float mag = expf((float)e * lr * dt), ang = (float)e * li * dt; float sn, cs; sincosf(ang, &sn, &cs);
        apr[idx] = mag * cs; api[idx] = mag * sn;
    }
    if (F.tid < 128) { const int d = F.tid >> 6, p = F.tid & 63; const size_t gi = (size_t)((l * 2 + d) * 32 + g);
        ccr[F.tid] = c_re[(gi * 16 + c) * 64 + p]; cci[F.tid] = c_im[(gi * 16 + c) * 64 + p]; }
    __syncthreads();
    for (int idx = F.tid; idx < 2 * 64 * 16; idx += 512) {
        const int d = idx >> 10, p = (idx >> 4) & 63, c2 = idx & 15; const size_t gi = (size_t)((l * 2 + d) * 32 + g);
        const float lr = lam_re[gi * 64 + p], li = lam_im[gi * 64 + p];
        const float ar = apr[(d * 33 + 1) * 64 + p], ai = api[(d * 33 + 1) * 64 + p], den = lr * lr + li * li;
        const float fr_ = ((ar - 1.0f) * lr + ai * li) / den, fi_ = (ai * lr - (ar - 1.0f) * li) / den;
        const float br = b_re[(gi * 64 + p) * 16 + c2], bi = b_im[(gi * 64 + p) * 16 + c2];
        bbr[idx] = fr_ * br - fi_ * bi; bbi[idx] = fr_ * bi + fi_ * br;
    }
    __syncthreads();
    for (int idx = F.tid; idx < 2 * 32 * 16; idx += 512) {
        const int d = idx >> 9, tau = (idx >> 4) & 31, c2 = idx & 15;
        const float* a_r = apr + (d * 33 + tau) * 64; const float* a_i = api + (d * 33 + tau) * 64;
        const float* c_r = ccr + d * 64; const float* c_i = cci + d * 64;
        const float* b_r = bbr + d * 1024 + c2; const float* b_i = bbi + d * 1024 + c2;
        float sacc = 0.f;
#pragma unroll 4
        for (int p = 0; p < 64; ++p) { const float wr_ = c_r[p] * a_r[p] - c_i[p] * a_i[p], wi_ = c_r[p] * a_i[p] + c_i[p] * a_r[p]; sacc += wr_ * b_r[p * 16] - wi_ * b_i[p * 16]; }
        Kt[idx] = sacc;
    }
    __syncthreads();
    bf16_t* M1 = (bf16_t*)(P.ws + WS_W + W_M1) + (size_t)g * 256 * 512;
    bf16_t* TM2 = (bf16_t*)(P.ws + WS_W + W_TM2) + (size_t)g * 512 * 768;
    for (int v = F.tid; v < 16 * 64; v += 512) {
        const int row = 16 * c + (v >> 6), cv = v & 63, s_ = cv >> 1, c0 = 8 * (cv & 1), d = row >> 7, ri = (row >> 6) & 1, p = row & 63;
        const int e = (d == 0) ? (31 - s_) : s_; const float ar = apr[(d * 33 + e) * 64 + p], ai = api[(d * 33 + e) * 64 + p];
        float o[8];
#pragma unroll
        for (int i = 0; i < 8; ++i) { const float br = bbr[d * 1024 + p * 16 + c0 + i], bi = bbi[d * 1024 + p * 16 + c0 + i]; o[i] = (ri == 0) ? (ar * br - ai * bi) : (ar * bi + ai * br); }
        u32x4 w; w.x = cvt_pk_bf16(o[0], o[1]); w.y = cvt_pk_bf16(o[2], o[3]); w.z = cvt_pk_bf16(o[4], o[5]); w.w = cvt_pk_bf16(o[6], o[7]);
        *(u32x4*)(M1 + (size_t)row * 512 + cv * 8) = w;
    }
    for (int v = F.tid; v < 32 * 96; v += 512) {
        const int t = v / 96, cv = v % 96, row = t * 16 + c;
        float o[8];
        if (cv < 64) {
            const int s_ = cv >> 1, c0 = 8 * (cv & 1);
#pragma unroll
            for (int i = 0; i < 8; ++i) {
                float val = 0.f;
                if (t >= s_) val += Kt[(0 * 32 + (t - s_)) * 16 + c0 + i];
                if (s_ >= t) val += Kt[(1 * 32 + (s_ - t)) * 16 + c0 + i];
                if (t == s_ && c == c0 + i) val += dsk[c];
                o[i] = val;
            }
        } else {
            const int kk = (cv - 64) * 8, d = kk >> 7, ri = (kk >> 6) & 1, p0 = kk & 63, e = (d == 0) ? (t + 1) : (32 - t);
#pragma unroll
            for (int i = 0; i < 8; ++i) {
                const int p = p0 + i; const float cr = ccr[d * 64 + p], ci = cci[d * 64 + p], ar = apr[(d * 33 + e) * 64 + p], ai = api[(d * 33 + e) * 64 + p];
                o[i] = (ri == 0) ? (cr * ar - ci * ai) : -(cr * ai + ci * ar);
            }
        }
        u32x4 w; w.x = cvt_pk_bf16(o[0], o[1]); w.y = cvt_pk_bf16(o[2], o[3]); w.z = cvt_pk_bf16(o[4], o[5]); w.w = cvt_pk_bf16(o[6], o[7]);
        *(u32x4*)(TM2 + (size_t)row * 768 + cv * 8) = w;
    }
    __syncthreads();
}

__device__ __forceinline__ void prep_layer(const Frame& F, const Params& P, int l) {
    for (int it = F.bid; it < 512; it += F.G) prep_s5_part(F, P, l, it >> 4, it & 15);
    __syncthreads();
    prep_weights(F, P, l);
}

__device__ __forceinline__ void phase_adaln(const Frame& F, const Params& P) {
    float* MOD = (float*)(P.ws + WS_MOD); float* TAB = (float*)(P.ws + WS_TAB);
    const float* cvec = P.in[1]; const float* cctx = P.in[3]; const float* w_ada = P.in[4]; const float* b_ada = P.in[5];
    float* sl = (float*)F.lds;
    for (int i = F.tid; i < 5 * 1024; i += 512) { const float cv = (i < 4096) ? cvec[i] : cctx[i - 4096]; sl[i] = cv / (1.0f + __expf(-cv)); }
    __syncthreads();
    for (int it = F.bid; it < 768; it += F.G) {
        const int l = it / 384, r = it % 384, cb = r / 16, ks = r % 16;
        const int col = cb * 256 + (F.tid & 255), kh = F.tid >> 8, kbeg = ks * 64 + kh * 32;
        float a[5] = {0.f, 0.f, 0.f, 0.f, 0.f};
#pragma unroll 8
        for (int k = kbeg; k < kbeg + 32; ++k) {
            const float w = w_ada[((size_t)l * 1024 + k) * 6144 + col];
#pragma unroll
            for (int mb = 0; mb < 5; ++mb) a[mb] += sl[mb * 1024 + k] * w;
        }
        const float bias = (ks == 0 && kh == 0) ? b_ada[l * 6144 + col] : 0.f;
#pragma unroll
        for (int mb = 0; mb < 5; ++mb) atomicAdd(&MOD[(l * 5 + mb) * 6144 + col], a[mb] + bias);
    }
    const int gt = F.bid * 512 + F.tid;
    if (gt < 2048) {
        const int p = gt >> 4, i = gt & 15;
        const float invf = exp2f(-(float)i * (13.287712379549449f / 16.0f)); const float ang = (float)p * invf;
        float sn, cs; sincosf(ang, &sn, &cs);
        TAB[gt * 2] = cs; TAB[gt * 2 + 1] = sn;
    }
}

__device__ __forceinline__ void phase_norm(const Frame& F, const Params& P, int l, int which, int nrows, bf16_t* HB) {
    const float* xl = (l == 0 && which == 0) ? P.in[0] : P.out; const float* xc = (l == 0 && which == 0) ? P.in[2] : (const float*)(P.ws + WS_XC);
    const float* gn = P.in[6] + (l * 2 + which) * 1024; const float* MOD = (const float*)(P.ws + WS_MOD) + l * 5 * 6144;
    bf16_t* H = (bf16_t*)(P.ws + WS_H);
    const int gw = F.bid * 8 + F.wave, NGW = F.G * 8;
    const int nblk = (NLAT >> 4) + (nrows > NLAT ? nrows - NLAT : 0);
    for (int blk = gw; blk < nblk; blk += NGW) {
      const int r0 = (blk < (NLAT >> 4)) ? (blk << 4) : NLAT + (blk - (NLAT >> 4)), nr = (blk < (NLAT >> 4)) ? 16 : 1, mb = (r0 < NLAT) ? (r0 >> 13) : 4;
      const float* sh = MOD + mb * 6144 + (which ? 3072 : 0); const float* sc = sh + 1024;
      f32x4 gsv[4], shv[4];
#pragma unroll
      for (int j = 0; j < 4; ++j) { const int col = 4 * F.lane + 256 * j; gsv[j] = *(const f32x4*)(gn + col) * (*(const f32x4*)(sc + col) + 1.0f); shv[j] = *(const f32x4*)(sh + col); }
#pragma unroll 2
      for (int rr = 0; rr < nr; ++rr) {
        const int row = r0 + rr;
        const float* xr = (row < NLAT) ? xl + (size_t)row * 1024 : xc + (size_t)(row - NLAT) * 1024;
        f32x4 v[4]; float ss = 0.f;
#pragma unroll
        for (int j = 0; j < 4; ++j) v[j] = *(const f32x4*)(xr + 4 * F.lane + 256 * j);
        if (l == 0 && which == 1 && row >= NLAT) {
            const float* cin = P.in[2] + (size_t)(row - NLAT) * 1024 + 4 * F.lane;
            const float* pp = (const float*)(P.ws + WS_AR + AR_PG4) + (size_t)(row - NLAT) * 1024 + 4 * F.lane;
            float* xo = (float*)(P.ws + WS_XC) + (size_t)(row - NLAT) * 1024 + 4 * F.lane;
#pragma unroll
            for (int j = 0; j < 4; ++j) {
                v[j] = *(const f32x4*)(cin + 256 * j);
#pragma unroll
                for (int kp = 0; kp < 3; ++kp) v[j] += *(const f32x4*)(pp + (size_t)kp * NCTX * 1024 + 256 * j);
                *(f32x4*)(xo + 256 * j) = v[j];
            }
        }
        if (l == 1 && which == 0 && row >= NLAT) {
            const float* pp = (const float*)(P.ws + WS_AR + AR_PART) + (size_t)(row - NLAT) * 1024 + 4 * F.lane;
#pragma unroll
            for (int kp = 0; kp < 4; ++kp)
#pragma unroll
                for (int j = 0; j < 4; ++j) v[j] += *(const f32x4*)(pp + (size_t)kp * NCTX * 1024 + 256 * j);
        }
#pragma unroll
        for (int j = 0; j < 4; ++j) ss += (v[j][0] * v[j][0] + v[j][1] * v[j][1]) + (v[j][2] * v[j][2] + v[j][3] * v[j][3]);
        ss = wave_sum(ss); const float rinv = rsqrtf(ss * (1.0f / 1024.0f) + EPS);
#pragma unroll
        for (int j = 0; j < 4; ++j) {
            const int col = 4 * F.lane + 256 * j;
            const f32x4 y = v[j] * rinv * gsv[j] + shv[j];
            u32x2 w; w.x = cvt_pk_bf16(y[0], y[1]); w.y = cvt_pk_bf16(y[2], y[3]);
            *(u32x2*)(H + (size_t)row * 1024 + col) = w;
            if (HB && (((row + 2) & 127) < 4)) *(u32x2*)(HB + (size_t)(4 * ((row + 2) >> 7) + ((row + 2) & 127)) * 1024 + col) = w;
        }
      }
    }
}

__device__ __forceinline__ void phase_scan(const Frame& F, const Params& P, int l) {
    const float* S = (const float*)(P.ws + WS_AR + AR_S); bf16_t* UC = (bf16_t*)(P.ws + WS_AR + AR_UC);
    const float* lam_re = P.in[9]; const float* lam_im = P.in[10]; const float* log_dt = P.in[11];
    const int gw = F.bid * 8 + F.wave, NGW = F.G * 8;
    for (int ww = gw; ww < 256; ww += NGW) {
        const int g = ww >> 3, b = (ww >> 1) & 3, d = ww & 1, p = F.lane; const int gi = (l * 2 + d) * 32 + g;
        const float lr = lam_re[gi * 64 + p], li = lam_im[gi * 64 + p], dt = expf(log_dt[gi]);
        const float mag = expf(32.0f * lr * dt); float sn, cs; sincosf(32.0f * li * dt, &sn, &cs);
        const float aLr = mag * cs, aLi = mag * sn;
        const int ctxb = (NLAT + 256 * b) / 32, latb = 256 * b;
        float cr = 0.f, ci = 0.f;
        auto chunk_of = [&](int j) -> int { return (j < 8) ? (ctxb + (d ? 7 - j : j)) : (latb + (d ? 255 - (j - 8) : (j - 8))); };
        float sr[8], si[8], nr_[8], ni_[8];
#pragma unroll
        for (int q = 0; q < 8; ++q) { const float* sp = S + ((size_t)g * CHPAD + chunk_of(q)) * 256 + d * 128 + p; sr[q] = sp[0]; si[q] = sp[64]; }
        for (int j0 = 0; j0 < 264; j0 += 8) {
            if (j0 + 8 < 264) {
#pragma unroll
                for (int q = 0; q < 8; ++q) { const float* sp = S + ((size_t)g * CHPAD + chunk_of(j0 + 8 + q)) * 256 + d * 128 + p; nr_[q] = sp[0]; ni_[q] = sp[64]; }
            }
#pragma unroll
            for (int q = 0; q < 8; ++q) {
                bf16_t* cp = UC + ((size_t)g * CHPAD + chunk_of(j0 + q)) * 768 + 512 + d * 128 + p;
                cp[0] = (bf16_t)(cvt_pk_bf16(cr, 0.f) & 0xffffu); cp[64] = (bf16_t)(cvt_pk_bf16(ci, 0.f) & 0xffffu);
                const float nr = aLr * cr - aLi * ci + sr[q], ni = aLr * ci + aLi * cr + si[q]; cr = nr; ci = ni;
            }
#pragma unroll
            for (int q = 0; q < 8; ++q) { sr[q] = nr_[q]; si[q] = ni_[q]; }
        }
    }
}

__device__ __forceinline__ s16x4 ld_tr(const unsigned char* p) { return __builtin_bit_cast(s16x4, __builtin_amdgcn_ds_read_tr16_b64_v4i16((LAS s16x4*)p)); }

template <int DV>
__device__ __forceinline__ void attn_pass(const int tid, unsigned char* smem, const bf16_t* Q0, int qpitch, const bf16_t* Kb, int kpitch, const bf16_t* Vb, int vpitch,
                                          int b, int ntiles, float kmax, f32x16 (&o)[DV / 32], float& linv) {
    constexpr int KP = 144, VP = DV * 2 + 64, KBYTES = 64 * KP, VBYTES = 64 * VP, BUF = KBYTES + VBYTES, NV = DV / 64;
    const int lane = tid & 63, wid = __builtin_amdgcn_readfirstlane(tid >> 6), r32 = lane & 31, hi = lane >> 5;
    bf16x8 qf[4];
    { const bf16_t* qp = Q0 + (size_t)(wid * 32 + r32) * qpitch + 8 * hi;
#pragma unroll
      for (int ds = 0; ds < 4; ++ds) qf[ds] = *(const bf16x8*)(qp + 16 * ds); }
    float ssq = 0.f;
#pragma unroll
    for (int ds = 0; ds < 4; ++ds)
#pragma unroll
        for (int j = 0; j < 8; ++j) { const float f = bf2f((unsigned short)qf[ds][j]); ssq += f * f; }
    ssq = sum_x32(ssq);
    const float nshift = -sqrtf(ssq) * kmax;
#pragma unroll
    for (int d0 = 0; d0 < DV / 32; ++d0)
#pragma unroll
        for (int r = 0; r < 16; ++r) o[d0][r] = 0.f;
    float lsum = 0.f;
    const int krow = tid >> 3, kch = tid & 7;
    u32x4 kreg, vreg[NV];
    auto tile_row = [&](int kt) -> size_t { return kt < 4 ? (size_t)(NLAT + 256 * b + 64 * kt) : (size_t)(SEQ * b + 64 * (kt - 4)); };
    auto gload = [&](int kt) {
        const size_t rb = tile_row(kt);
        kreg = *(const u32x4*)(Kb + (rb + krow) * kpitch + 8 * kch);
#pragma unroll
        for (int i = 0; i < NV; ++i) { const int item = tid + 512 * i; const int vr = (DV == 64) ? (item >> 3) : (item >> 4), vc = (DV == 64) ? (item & 7) : (item & 15);
            vreg[i] = *(const u32x4*)(Vb + (rb + vr) * vpitch + 8 * vc); }
    };
    auto lwrite = [&](int buf) {
        unsigned char* Ks = smem + buf * BUF; unsigned char* Vs = Ks + KBYTES;
        *(u32x4*)(Ks + krow * KP + 16 * kch) = kreg;
#pragma unroll
        for (int i = 0; i < NV; ++i) { const int item = tid + 512 * i; const int vr = (DV == 64) ? (item >> 3) : (item >> 4), vc = (DV == 64) ? (item & 7) : (item & 15);
            *(u32x4*)(Vs + vr * VP + 16 * vc) = vreg[i]; }
    };
    gload(0); lwrite(0); __syncthreads();
    const int nhalf = (lane >> 4) & 1, q4 = (lane & 15) >> 2, p4 = lane & 3;
    for (int kt = 0; kt < ntiles; ++kt) {
        if (kt + 1 < ntiles) gload(kt + 1);
        const unsigned char* Ks = smem + (kt & 1) * BUF; const unsigned char* Vs = Ks + KBYTES;
        const unsigned char* kp = Ks + r32 * KP + hi * 16;
        bf16x8 pf[2][2];
#pragma unroll
        for (int kb = 0; kb < 2; ++kb) {
            f32x16 s;
#pragma unroll
            for (int r = 0; r < 16; ++r) s[r] = nshift;
#pragma unroll
            for (int ds = 0; ds < 4; ++ds) {
                const bf16x8 kf = *(const bf16x8*)(kp + kb * 32 * KP + ds * 32);
                s = __builtin_amdgcn_mfma_f32_32x32x16_bf16(kf, qf[ds], s, 0, 0, 0);
            }
            float ls = 0.f;
#pragma unroll
            for (int r = 0; r < 16; ++r) { s[r] = __builtin_amdgcn_exp2f(s[r]); ls += s[r]; }
            lsum += ls;
#pragma unroll
            for (int j = 0; j < 2; ++j) {
                u32x4 w0;
                w0.x = cvt_pk_bf16(s[8 * j + 0], s[8 * j + 1]); w0.y = cvt_pk_bf16(s[8 * j + 2], s[8 * j + 3]); w0.z = cvt_pk_bf16(s[8 * j + 4], s[8 * j + 5]); w0.w = cvt_pk_bf16(s[8 * j + 6], s[8 * j + 7]);
                pf[kb][j] = __builtin_bit_cast(bf16x8, w0);
            }
        }
        const unsigned char* vp = Vs + (4 * hi + q4) * VP + (16 * nhalf + 4 * p4) * 2;
#pragma unroll
        for (int d0 = 0; d0 < DV / 32; ++d0) {
#pragma unroll
            for (int kb = 0; kb < 2; ++kb)
#pragma unroll
                for (int j = 0; j < 2; ++j) {
                    const unsigned char* a = vp + (32 * kb + 16 * j) * VP + d0 * 64;
                    const s16x4 lo = ld_tr(a), h4 = ld_tr(a + 8 * VP);
                    const bf16x8 vf = (bf16x8){lo[0], lo[1], lo[2], lo[3], h4[0], h4[1], h4[2], h4[3]};
                    o[d0] = __builtin_amdgcn_mfma_f32_32x32x16_bf16(vf, pf[kb][j], o[d0], 0, 0, 0);
                }
            if (d0 & 1) __builtin_amdgcn_sched_barrier(0);
        }
        if (kt + 1 < ntiles) lwrite((kt + 1) & 1);
        __syncthreads();
    }
    lsum = sum_x32(lsum);
    linv = 1.0f / lsum;
}

__device__ __forceinline__ void attn_pass_A2(const int tid, unsigned char* smem, const bf16_t* Q0w, int qpitch, const bf16_t* Kb, int kpitch, const bf16_t* Vb, int vpitch,
                                             int b, int ntiles, float kmax, f32x16 (&o)[2][2], float (&linv)[2]) {
    constexpr int KP = 144, VP = 192, KBYTES = 64 * KP, VBYTES = 64 * VP, BUF = KBYTES + VBYTES;
    const int lane = tid & 63, r32 = lane & 31, hi = lane >> 5;
    float nshift[2], lsum[2] = {0.f, 0.f};
    unsigned char* qs = smem + 2 * BUF + ((tid >> 6) * 64 + r32) * KP + hi * 16;
#pragma unroll
    for (int qb = 0; qb < 2; ++qb) {
        const bf16_t* qp = Q0w + (size_t)(32 * qb + r32) * qpitch + 8 * hi; float ssq = 0.f;
#pragma unroll
        for (int ds = 0; ds < 4; ++ds) { const bf16x8 qv = *(const bf16x8*)(qp + 16 * ds); *(bf16x8*)(qs + qb * 32 * KP + ds * 32) = qv;
#pragma unroll
            for (int j = 0; j < 8; ++j) { const float f = bf2f((unsigned short)qv[j]); ssq += f * f; } }
        nshift[qb] = -sqrtf(sum_x32(ssq)) * kmax;
#pragma unroll
        for (int d0 = 0; d0 < 2; ++d0)
#pragma unroll
            for (int r = 0; r < 16; ++r) o[qb][d0][r] = 0.f;
    }
    const int krow = tid >> 3, kch = tid & 7;
    u32x4 kreg, vreg;
    auto gload = [&](int kt) {
        const size_t rb = kt < 4 ? (size_t)(NLAT + 256 * b + 64 * kt) : (size_t)(SEQ * b + 64 * (kt - 4));
        kreg = *(const u32x4*)(Kb + (rb + krow) * kpitch + 8 * kch); vreg = *(const u32x4*)(Vb + (rb + krow) * vpitch + 8 * kch);
    };
    auto lwrite = [&](int buf) { unsigned char* Ks = smem + buf * BUF; *(u32x4*)(Ks + krow * KP + 16 * kch) = kreg; *(u32x4*)(Ks + KBYTES + krow * VP + 16 * kch) = vreg; };
    gload(0); lwrite(0); __syncthreads();
    const int nhalf = (lane >> 4) & 1, q4 = (lane & 15) >> 2, p4 = lane & 3;
    for (int kt = 0; kt < ntiles; ++kt) {
        if (kt + 1 < ntiles) gload(kt + 1);
        const unsigned char* Ks = smem + (kt & 1) * BUF; const unsigned char* Vs = Ks + KBYTES;
        const unsigned char* kp = Ks + r32 * KP + hi * 16;
        const unsigned char* vp = Vs + (4 * hi + q4) * VP + (16 * nhalf + 4 * p4) * 2;
#pragma unroll
        for (int kb = 0; kb < 2; ++kb) {
            bf16x8 pf[2][2];
            {
                f32x16 s0, s1;
#pragma unroll
                for (int r = 0; r < 16; ++r) { s0[r] = nshift[0]; s1[r] = nshift[1]; }
#pragma unroll
                for (int ds = 0; ds < 4; ++ds) {
                    const bf16x8 kf = *(const bf16x8*)(kp + kb * 32 * KP + ds * 32);
                    const bf16x8 q0 = *(const bf16x8*)(qs + ds * 32), q1 = *(const bf16x8*)(qs + 32 * KP + ds * 32);
                    s0 = __builtin_amdgcn_mfma_f32_32x32x16_bf16(kf, q0, s0, 0, 0, 0);
                    s1 = __builtin_amdgcn_mfma_f32_32x32x16_bf16(kf, q1, s1, 0, 0, 0);
                }
                float l0 = 0.f, l1 = 0.f;
#pragma unroll
                for (int r = 0; r < 16; ++r) { s0[r] = __builtin_amdgcn_exp2f(s0[r]); l0 += s0[r]; }
#pragma unroll
                for (int r = 0; r < 16; ++r) { s1[r] = __builtin_amdgcn_exp2f(s1[r]); l1 += s1[r]; }
                lsum[0] += l0; lsum[1] += l1;
#pragma unroll
                for (int j = 0; j < 2; ++j) {
                    u32x4 w0, w1;
                    w0.x = cvt_pk_bf16(s0[8 * j + 0], s0[8 * j + 1]); w0.y = cvt_pk_bf16(s0[8 * j + 2], s0[8 * j + 3]); w0.z = cvt_pk_bf16(s0[8 * j + 4], s0[8 * j + 5]); w0.w = cvt_pk_bf16(s0[8 * j + 6], s0[8 * j + 7]);
                    w1.x = cvt_pk_bf16(s1[8 * j + 0], s1[8 * j + 1]); w1.y = cvt_pk_bf16(s1[8 * j + 2], s1[8 * j + 3]); w1.z = cvt_pk_bf16(s1[8 * j + 4], s1[8 * j + 5]); w1.w = cvt_pk_bf16(s1[8 * j + 6], s1[8 * j + 7]);
                    pf[0][j] = __builtin_bit_cast(bf16x8, w0); pf[1][j] = __builtin_bit_cast(bf16x8, w1);
                }
            }
            __builtin_amdgcn_sched_barrier(0);
#pragma unroll
            for (int d0 = 0; d0 < 2; ++d0)
#pragma unroll
                for (int j = 0; j < 2; ++j) {
                    const unsigned char* a = vp + (32 * kb + 16 * j) * VP + d0 * 64;
                    const s16x4 lo = ld_tr(a), h4 = ld_tr(a + 8 * VP);
                    const bf16x8 vf = (bf16x8){lo[0], lo[1], lo[2], lo[3], h4[0], h4[1], h4[2], h4[3]};
                    o[0][d0] = __builtin_amdgcn_mfma_f32_32x32x16_bf16(vf, pf[0][j], o[0][d0], 0, 0, 0);
                    o[1][d0] = __builtin_amdgcn_mfma_f32_32x32x16_bf16(vf, pf[1][j], o[1][d0], 0, 0, 0);
                }
            __builtin_amdgcn_sched_barrier(0);
        }
        if (kt + 1 < ntiles) lwrite((kt + 1) & 1);
        __syncthreads();
    }
    linv[0] = 1.0f / sum_x32(lsum[0]); linv[1] = 1.0f / sum_x32(lsum[1]);
}

__device__ __forceinline__ void attn_unit_A2(const Frame& F, const Params& P, int l, int b, int h, size_t qrow0, int nq, int ntiles, float kmax, size_t ooff) {
    bf16_t* YAB = (bf16_t*)(P.ws + WS_AR + AR_YAB); const bf16_t* KA = (const bf16_t*)(P.ws + WS_AR + AR_KA); const bf16_t* VA = (const bf16_t*)(P.ws + WS_AR + AR_VA);
    f32x16 o[2][2]; float linv[2];
    { const int wrow = (F.wave * 64 < nq) ? F.wave * 64 : (F.wave - 4) * 64;
      attn_pass_A2(F.tid, F.lds, YAB + (qrow0 + wrow) * 1024 + 64 * h, 1024, KA + 64 * (h >> 2), 128, VA + 64 * (h >> 2), 128, b, ntiles, kmax, o, linv); }
    int t2 = F.tid; asm volatile("" : "+v"(t2));
    const int r32 = t2 & 31, hi = (t2 >> 5) & 1, wv = t2 >> 6;
    if (wv * 64 < nq) {
#pragma unroll
        for (int qb = 0; qb < 2; ++qb) {
            bf16_t* op = YAB + ooff + (qrow0 + wv * 64 + 32 * qb + r32) * 1024 + 64 * h + 4 * hi;
#pragma unroll
            for (int d0 = 0; d0 < 2; ++d0)
#pragma unroll
                for (int rg = 0; rg < 4; ++rg) {
                    u32x2 w; w.x = cvt_pk_bf16(o[qb][d0][4 * rg] * linv[qb], o[qb][d0][4 * rg + 1] * linv[qb]); w.y = cvt_pk_bf16(o[qb][d0][4 * rg + 2] * linv[qb], o[qb][d0][4 * rg + 3] * linv[qb]);
                    *(u32x2*)(op + 32 * d0 + 8 * rg) = w;
                }
        }
    }
}

__device__ __forceinline__ void attn_unit_C(const Frame& F, const Params& P, int l, int b, int h, size_t qrow0, int ntiles, float kmax, size_t ooff) {
    bf16_t* YD = (bf16_t*)(P.ws + WS_AR + AR_YD); const bf16_t* KC = (const bf16_t*)(P.ws + WS_AR + AR_KC); const bf16_t* VC = (const bf16_t*)(P.ws + WS_AR + AR_VC);
#pragma unroll 1
    for (int sub = 0; sub < 2; ++sub) {
        f32x16 o[4]; float linv;
        attn_pass<128>(F.tid, F.lds, YD + qrow0 * 1024 + 128 * h + 64 * sub, 1024, KC + 128 * h + 64 * sub, 512, VC + 128 * h, 512, b, ntiles, kmax, o, linv);
        int t2 = F.tid; asm volatile("" : "+v"(t2));
        const int r32 = t2 & 31, hi = (t2 >> 5) & 1, wv = t2 >> 6;
        float* st = (float*)(P.ws + WS_AR + AR_O1) + (size_t)F.bid * 32768 + (size_t)t2 * 4;
        if (sub == 0) {
#pragma unroll
            for (int d0 = 0; d0 < 4; ++d0)
#pragma unroll
                for (int rg = 0; rg < 4; ++rg)
                    *(f32x4*)(st + (size_t)(d0 * 4 + rg) * 2048) = (f32x4){o[d0][4 * rg] * linv, o[d0][4 * rg + 1] * linv, o[d0][4 * rg + 2] * linv, o[d0][4 * rg + 3] * linv};
        } else {
            const float* lv = P.in[19] + l * 256 + (t2 & 63);
            const float lam_init = (l == 0) ? 0.2f : 0.35550906f;
            const float lam = expf(wave_sum(lv[0] * lv[64])) - expf(wave_sum(lv[128] * lv[192])) + lam_init;
            const float nl = -lam * linv; float ss = 0.f;
#pragma unroll
            for (int d0 = 0; d0 < 4; ++d0)
#pragma unroll
                for (int rg = 0; rg < 4; ++rg) {
                    const f32x4 s1 = *(const f32x4*)(st + (size_t)(d0 * 4 + rg) * 2048);
#pragma unroll
                    for (int e = 0; e < 4; ++e) { const float dd = s1[e] + nl * o[d0][4 * rg + e]; o[d0][4 * rg + e] = dd; ss += dd * dd; }
                }
            ss = sum_x32(ss);
            const float rn = rsqrtf(ss * (1.0f / 128.0f) + EPS) * (1.0f - lam_init);
            const float* go = P.in[20] + l * 128;
            bf16_t* op = YD + ooff + (qrow0 + wv * 32 + r32) * 1024 + 128 * h + 4 * hi;
#pragma unroll
            for (int d0 = 0; d0 < 4; ++d0)
#pragma unroll
                for (int rg = 0; rg < 4; ++rg) {
                    const f32x4 gv = *(const f32x4*)(go + 32 * d0 + 8 * rg + 4 * hi);
                    u32x2 w; w.x = cvt_pk_bf16(o[d0][4 * rg] * rn * gv[0], o[d0][4 * rg + 1] * rn * gv[1]); w.y = cvt_pk_bf16(o[d0][4 * rg + 2] * rn * gv[2], o[d0][4 * rg + 3] * rn * gv[3]);
                    *(u32x2*)(op + 32 * d0 + 8 * rg) = w;
                }
        }
    }
}

__device__ __forceinline__ void phase_attn(const Frame& F0, const Params& P, int l, size_t ooffA, size_t ooffC) {
    const int total = (l == 0) ? 1072 : 1024;
    for (int i = F0.bid; i < total; i += F0.G) {
        Frame F = F0; { int t = F0.tid; asm volatile("" : "+v"(t)); F.tid = t; F.lane = t & 63; F.wave = __builtin_amdgcn_readfirstlane(t >> 6); }
        int isC, b, h, nt, nq; size_t qrow0;
        if (i < 512) { const int combo = ((i >> 8) << 3) | (i & 7), qb = (i >> 3) & 31; isC = 1; b = combo >> 2; h = combo & 3; qrow0 = (size_t)b * SEQ + 256 * qb; nt = 132; nq = 256; }
        else if (i < 1024) { const int u = i - 512, w = u & 255, slot = w >> 3, combo = (u >> 8) * 16 + (w & 7) * 2 + (slot >> 4); isC = 0; b = combo >> 3; h = combo & 7; qrow0 = (size_t)b * SEQ + 512 * (slot & 15); nt = 132; nq = 512; }
        else { const int u = i - 1024, r = u % 12; b = u / 12; isC = r < 4; h = isC ? r : r - 4; qrow0 = (size_t)NLAT + 256 * b; nt = 4; nq = 256; }
        const float kmax = 8.08f * wave_max(fabsf(P.in[8][(l * 4 + (isC ? 3 : 1)) * 64 + F.lane]));
        if (isC) attn_unit_C(F, P, l, b, h, qrow0, nt, kmax, ooffC); else attn_unit_A2(F, P, l, b, h, qrow0, nq, nt, kmax, ooffA);
    }
}

__device__ __forceinline__ void phase_fixup(const Frame& F, const Params& P, int l, int nrows) {
    const bf16_t* UB = (const bf16_t*)(P.ws + WS_AR + AR_UB); bf16_t* ACT = (bf16_t*)(P.ws + WS_AR + AR_ACT);
    const float* cw = P.in[24] + (size_t)l * 3 * 5632; const float* cb = P.in[25] + (size_t)l * 5632;
    const int nitems = NBGRP * 2 * 352;
    for (int it = F.bid * 512 + F.tid; it < nitems; it += F.G * 512) {
        const int fc = it % 352, js = it / 352, j = js >> 1, sd = js & 1, f0 = 8 * fc;
        const int row = 128 * j - 1 + sd;
        if (row < 0 || row >= nrows) continue;
        const int tpos = (row < NLAT) ? (row & (SEQ - 1)) : ((row - NLAT) & (CTXL - 1)), seqlen = (row < NLAT) ? SEQ : CTXL;
        const int ca = 256 * (f0 >> 7) + (f0 & 127);
        const bf16_t* ub = UB + (size_t)(4 * j + sd) * 5632 + ca;
        const u32x4 z = (u32x4){0, 0, 0, 0};
        const u32x4 pa = (tpos > 0) ? *(const u32x4*)(ub) : z, pg = (tpos > 0) ? *(const u32x4*)(ub + 128) : z;
        const u32x4 ca_ = *(const u32x4*)(ub + 5632), cg_ = *(const u32x4*)(ub + 5632 + 128);
        const u32x4 na = (tpos + 1 < seqlen) ? *(const u32x4*)(ub + 11264) : z, ng = (tpos + 1 < seqlen) ? *(const u32x4*)(ub + 11264 + 128) : z;
        float o[8];
#pragma unroll
        for (int i = 0; i < 4; ++i) {
            const int c0 = f0 + 2 * i, c1 = c0 + 1;
            const float a0 = bflo(pa[i]) * cw[c0] + bflo(ca_[i]) * cw[5632 + c0] + bflo(na[i]) * cw[11264 + c0] + cb[c0];
            const float a1 = bfhi(pa[i]) * cw[c1] + bfhi(ca_[i]) * cw[5632 + c1] + bfhi(na[i]) * cw[11264 + c1] + cb[c1];
            const float g0 = bflo(pg[i]) * cw[2816 + c0] + bflo(cg_[i]) * cw[5632 + 2816 + c0] + bflo(ng[i]) * cw[11264 + 2816 + c0] + cb[2816 + c0];
            const float g1 = bfhi(pg[i]) * cw[2816 + c1] + bfhi(cg_[i]) * cw[5632 + 2816 + c1] + bfhi(ng[i]) * cw[11264 + 2816 + c1] + cb[2816 + c1];
            o[2 * i] = g0 * sigmoidf_(g0) * a0; o[2 * i + 1] = g1 * sigmoidf_(g1) * a1;
        }
        u32x4 w; w.x = cvt_pk_bf16(o[0], o[1]); w.y = cvt_pk_bf16(o[2], o[3]); w.z = cvt_pk_bf16(o[4], o[5]); w.w = cvt_pk_bf16(o[6], o[7]);
        *(u32x4*)(ACT + (size_t)row * 2816 + f0) = w;
    }
}

#ifndef PH_MASK
#define PH_MASK 0x1ffff
#endif
#define PHM(k) ((PH_MASK >> (k)) & 1)
#ifndef REP_MASK
#define REP_MASK 0
#endif
constexpr int NPHASE = 33;
constexpr int LDS_BYTES = 147456;

__global__ void __launch_bounds__(512, 2) mega_fwd(Params P) {
    extern __shared__ __attribute__((aligned(16))) unsigned char lds[];
    cg::grid_group grid = cg::this_grid();
    const int wave_s = __builtin_amdgcn_readfirstlane(threadIdx.x >> 6);
    volatile LAS unsigned* bst = (volatile LAS unsigned*)((LAS unsigned char*)lds + 131072 + 1024);
    if (threadIdx.x < 2) bst[threadIdx.x] = 0u;
    __syncthreads();
    (void)xcd_barrier_post((unsigned*)(P.ws + WS_BAR), bst);
    for (int ph = P.ph_lo; ph < P.ph_hi; ++ph) {
        if (ph > 0 && (((ph - 1) & 15) >= 13 || ((ph - 1) & 15) == 5 || ((ph - 1) & 15) == 11)) continue;
        const int nrep = (ph > 0 && P.rep_q == ((ph - 1) & 15)) ? P.rep_n + 1 : 1;
        for (int rep = 0; rep < nrep; ++rep) {
        int tid_l = wave_s * 64 + (int)__builtin_amdgcn_mbcnt_hi(~0u, __builtin_amdgcn_mbcnt_lo(~0u, 0u)), bid_l = blockIdx.x, g_l = gridDim.x; unsigned char* ws = P.ws;
        asm volatile("" : "+v"(tid_l)); asm volatile("" : "+s"(bid_l), "+s"(g_l), "+s"(ws));
        Frame F; F.lds = lds; F.tid = tid_l; F.lane = F.tid & 63; F.wave = __builtin_amdgcn_readfirstlane(F.tid >> 6); F.G = g_l; F.bid = bid_l;
        LAS unsigned char* ldsl = (LAS unsigned char*)lds;
        unsigned char* AR = ws + WS_AR; unsigned char* Wb = ws + WS_W;
        bf16_t* H = (bf16_t*)(ws + WS_H); float* XC = (float*)(ws + WS_XC); const float* MODall = (const float*)(ws + WS_MOD);
        if (ph == 0) {
            if (PHM(16)) { phase_adaln(F, P); prep_layer(F, P, 0); }
        } else {
            const int l = (ph - 1) >> 4, q = (ph - 1) & 15; const bool last = (l == 1);
            const float* MOD = MODall + l * 5 * 6144;
            const int nM_out = last ? 128 : 132;
            switch (q) {
            case 0: if (PHM(0)) { phase_norm(F, P, l, 0, MT, nullptr); if (l == 1) prep_layer(F, P, 1); } break;
            case 1: if (PHM(1)) {
                SchedPlain S{H, (const bf16_t*)(Wb + W_WIN), 1024, 1024, 132, 11, 16, F.G, F.bid, 0};
                EpiG1 E{(bf16_t*)(AR + AR_YAB), (bf16_t*)(AR + AR_YD), (bf16_t*)(AR + AR_KA), (bf16_t*)(AR + AR_VA), (bf16_t*)(AR + AR_KC), (bf16_t*)(AR + AR_VC), (bf16_t*)(AR + AR_UC),
                        P.in[8] + l * 256, (const float*)(ws + WS_TAB)};
                pg8::gemm_phase<EpiG1, SchedPlain, true, true>(ldsl, F.tid, 1024, 1024, S, E);
            } break;
            case 2: if (PHM(2)) {
                SchedS5 S{(const bf16_t*)(AR + AR_UC), (const bf16_t*)(Wb + W_M1), 512, 1, 8, F.G, F.bid, 5};
                EpiS E{(float*)(AR + AR_S)};
                pg8::gemm_phase<EpiS, SchedS5, true, true>(ldsl, F.tid, 768, 512, S, E);
            } break;
            case 3: if (PHM(3)) phase_scan(F, P, l); break;
            case 4: if (PHM(4)) {
                SchedS5 S{(const bf16_t*)(AR + AR_UC), (const bf16_t*)(Wb + W_TM2), 768, 2, 12, F.G, F.bid, last ? 4 : 5};
                EpiY E{(bf16_t*)(AR + AR_YD) + 512};
                pg8::gemm_phase<EpiY, SchedS5, true, true>(ldsl, F.tid, 768, 768, S, E);
            } break;
            case 6: if (PHM(6)) {
                {

                SchedPlain S{(const bf16_t*)(AR + AR_YD) + 512, (const bf16_t*)(Wb + W_GLU), 1024, 512, nM_out, 2, 8, F.G, F.bid, 0};
                EpiGLU E{(const bf16_t*)(AR + AR_YD) + 512, (bf16_t*)(AR + AR_YAB) + 512, P.in[18] + l * 512};
                pg8::gemm_phase<EpiGLU, SchedPlain, true, true>(ldsl, F.tid, 1024, 512, S, E);
                            }
                const bool dummy = rep + 1 < nrep;
                phase_attn(F, P, l, dummy ? (size_t)(250 * MiB - AR_YAB) / 2 : 0, dummy ? (size_t)(250 * MiB - AR_YD) / 2 : 0);
            } break;
            case 7: if (PHM(7)) {
                SchedMerge S{H, (const bf16_t*)(AR + AR_YAB), (const bf16_t*)(AR + AR_YD), (const bf16_t*)(Wb + W_BCAT), last ? 0 : 48, F.G, F.bid};
                EpiMerge E{(bf16_t*)(AR + AR_M), (float*)(AR + AR_SM) + (size_t)F.bid * 65536, (unsigned*)(AR + AR_SG) + (size_t)F.bid * 32768, F.tid, (bf16_t*)(AR + AR_MCTX)};
                pg8::gemm_phase<EpiMerge, SchedMerge, true, true>(ldsl, F.tid, 1024, 1536, S, E);
            } break;
            case 8: if (PHM(8)) {
                SchedG4 S{(const bf16_t*)(AR + AR_M), (const bf16_t*)(AR + AR_MCTX), (const bf16_t*)(Wb + W_OUT), last ? 0 : 48, F.G, F.bid};
                EpiRes E{l == 0 ? P.in[0] : P.out, l == 0 ? P.in[2] : XC, P.out, XC, MOD, 2048, (float*)(AR + AR_PG4)};
                pg8::gemm_phase<EpiRes, SchedG4, true, true>(ldsl, F.tid, 1024, 1024, S, E);
            } break;
            case 9: if (PHM(9)) phase_norm(F, P, l, 1, last ? NLAT : MT, (bf16_t*)(AR + AR_HB)); break;
            case 10: if (PHM(10)) {
                SchedUp S{H, (const bf16_t*)(AR + AR_HB), (const bf16_t*)(Wb + W_UP), nM_out, F.G, F.bid};
                EpiUpConv E{(bf16_t*)(AR + AR_ACT), last ? NLAT : MT, P.in[24] + (size_t)l * 3 * 5632, P.in[25] + (size_t)l * 5632};
                pg8::gemm_phase<EpiUpConv, SchedUp, true, true, true>(ldsl, F.tid, 1024, 1024, S, E);
            } break;
            case 11: if (PHM(11)) phase_fixup(F, P, l, last ? NLAT : MT); break;
            case 12: if (PHM(12)) {
                EpiRes E{P.out, XC, P.out, XC, MOD, 5120, (float*)(AR + AR_PART)};
                SchedG6c S{(const bf16_t*)(AR + AR_ACT), (const bf16_t*)(Wb + W_DOWN), F.G, F.bid, last ? 0 : 64};
                pg8::gemm_phase<EpiRes, SchedG6c, true, true>(ldsl, F.tid, 2816, 2816, S, E);
            } break;
            default: break;
            }
        }
        if (rep + 1 < nrep) __syncthreads();
        }
        if (ph + 1 < P.ph_hi && ph < NPHASE - 4) { if (ph == P.ph_lo) grid.sync(); else { XcdBarrier xb; xb.bar = (unsigned*)(P.ws + WS_BAR); xb.x = xb_xcc_id(); xb.st = (volatile LAS unsigned*)((LAS unsigned char*)lds + 131072 + 1024); xcd_barrier(xb); } }
    }
}

extern "C" void kernel_launch(void* const* d_in, const int* in_sizes, int n_in, void* d_out, int out_size, void* d_ws, size_t ws_size, hipStream_t stream) {
    static int grid = 0;
    if (grid == 0) {
        int dev = 0, cus = 0, per_cu = 0;
        if (hipGetDevice(&dev) != hipSuccess || hipDeviceGetAttribute(&cus, hipDeviceAttributeMultiprocessorCount, dev) != hipSuccess) { fprintf(stderr, "device query failed\n"); grid = -1; return; }
        if (hipFuncSetAttribute((const void*)mega_fwd, hipFuncAttributeMaxDynamicSharedMemorySize, LDS_BYTES) != hipSuccess) { fprintf(stderr, "hipFuncSetAttribute failed\n"); grid = -1; return; }
        if (hipOccupancyMaxActiveBlocksPerMultiprocessor(&per_cu, (const void*)mega_fwd, 512, LDS_BYTES) != hipSuccess || per_cu < 1) { fprintf(stderr, "occupancy query: %d\n", per_cu); per_cu = 1; }
        (void)hipGetLastError();
        grid = cus > 256 ? 256 : cus;
        if (n_in != 27 || out_size != NLAT * DM || ws_size < WS_TOTAL) { fprintf(stderr, "kernel_launch: unexpected shapes (n_in %d out %d ws %zu need %zu)\n", n_in, out_size, ws_size, (size_t)WS_TOTAL); grid = -1; return; }
    }
    if (grid < 0) return;
    (void)hipMemsetAsync((char*)d_ws + WS_MOD, 0, 512 * 1024, stream);
    Params p{};
    for (int i = 0; i < 27; ++i) p.in[i] = (const float*)d_in[i];
    p.out = (float*)d_out; p.ws = (unsigned char*)d_ws;
    p.rep_q = -1; p.rep_n = 0;
#ifdef PROBE_Q
    p.rep_q = PROBE_Q; p.rep_n = 1;
#endif
#if N_LAUNCH_MODE == 1
    p.ph_lo = 0; p.ph_hi = NPHASE;
    void* args[] = {&p};
    hipError_t e = hipLaunchCooperativeKernel((const void*)mega_fwd, dim3(grid), dim3(512), args, LDS_BYTES, stream);
    if (e != hipSuccess) fprintf(stderr, "cooperative launch failed: %s (grid %d)\n", hipGetErrorString(e), grid);
#else
    for (int ph = 0; ph < NPHASE; ++ph) {
        p.ph_lo = ph; p.ph_hi = ph + 1;
        hipLaunchKernelGGL(mega_fwd, dim3(grid), dim3(512), LDS_BYTES, stream, p);
    }
#endif
}
```

```cpp
#include <hip/hip_runtime.h>
#include <hip/hip_cooperative_groups.h>
#include <cstdio>
#include <cstdint>
namespace cg = cooperative_groups;

#ifndef N_LAUNCH_MODE
#define N_LAUNCH_MODE 1
#endif

#define LAS __attribute__((address_space(3)))
typedef unsigned short bf16_t;
typedef short bf16x8 __attribute__((ext_vector_type(8)));
typedef short s16x4 __attribute__((ext_vector_type(4)));
typedef float f32x4 __attribute__((ext_vector_type(4)));
typedef float f32x2 __attribute__((ext_vector_type(2)));
typedef float f32x16 __attribute__((ext_vector_type(16)));
typedef unsigned u32x4 __attribute__((ext_vector_type(4)));
typedef unsigned u32x2 __attribute__((ext_vector_type(2)));

constexpr int DM = 1024, NBATCH = 4, SEQ = 8192, CTXL = 256;
constexpr int NLAT = NBATCH * SEQ, NCTX = NBATCH * CTXL, MT = NLAT + NCTX;
constexpr int DFF = 2816, NIN = 5888, NMIX = 2816;
constexpr int NCHUNK = MT / 32, CHPAD = 1280;
constexpr float EPS = 1e-6f;
constexpr float QSCALE = 0.125f * 1.4426950408889634f;

constexpr size_t MiB = 1u << 20;
constexpr size_t WS_MOD = 0;
constexpr size_t WS_BAR = 384 * 1024;
constexpr size_t WS_TAB = 512 * 1024;
constexpr size_t WS_W = 1 * MiB;
constexpr size_t W_WIN = 0, W_BCAT = W_WIN + (size_t)2816 * 1024 * 2, W_GLU = W_BCAT + (size_t)3 * 1024 * 1536 * 2, W_OUT = W_GLU + (size_t)512 * 512 * 2,
                 W_UP = W_OUT + (size_t)1024 * 1024 * 2, W_DOWN = W_UP + (size_t)5632 * 1024 * 2, W_M1 = W_DOWN + (size_t)1024 * 2816 * 2,
                 W_TM2 = W_M1 + (size_t)32 * 256 * 512 * 2, W_END = W_TM2 + (size_t)32 * 512 * 768 * 2;
static_assert(W_END <= 66 * MiB, "weights");
constexpr size_t WS_H = 67 * MiB;
constexpr size_t WS_XC = 133 * MiB;
constexpr size_t WS_AR = 137 * MiB;
constexpr size_t AR_YAB = 0, AR_YD = 66 * MiB, AR_KA = 132 * MiB, AR_VA = 141 * MiB, AR_KC = 150 * MiB, AR_VC = 183 * MiB, AR_UC = 216 * MiB, AR_S = 276 * MiB, AR_END = 316 * MiB;
constexpr size_t AR_O1 = 216 * MiB;
constexpr size_t AR_M = 132 * MiB, AR_SM = 198 * MiB, AR_SG = 262 * MiB;
constexpr size_t AR_ACT = 0, AR_UB = 188 * MiB, AR_HB = 204 * MiB;
constexpr size_t AR_PART = 208 * MiB;
constexpr size_t AR_MCTX = 296 * MiB, AR_PG4 = 302 * MiB;
constexpr int NBGRP = 265;
constexpr size_t WS_TOTAL = WS_AR + AR_END;
static_assert((size_t)32 * CHPAD * 768 * 2 <= 60 * MiB && (size_t)32 * CHPAD * 256 * 4 <= 40 * MiB, "s5 buffers");
static_assert((size_t)MT * 2816 * 2 <= 188 * MiB && AR_UB + (size_t)1280 * 5632 * 2 <= AR_HB && AR_HB + (size_t)1280 * 1024 * 2 <= AR_END, "ffn buffers");

struct Params {
    const float* in[27];
    float* out; unsigned char* ws;
    int ph_lo, ph_hi, rep_q, rep_n;
};

typedef __bf16 bf16x2_t __attribute__((ext_vector_type(2)));
__device__ __forceinline__ unsigned cvt_pk_bf16(float lo, float hi) { f32x2 v = {lo, hi}; bf16x2_t b = __builtin_convertvector(v, bf16x2_t); return __builtin_bit_cast(unsigned, b); }
__device__ __forceinline__ float bf2f(unsigned short b) { return __uint_as_float((unsigned)b << 16); }
__device__ __forceinline__ float bflo(unsigned w) { return __uint_as_float(w << 16); }
__device__ __forceinline__ float bfhi(unsigned w) { return __uint_as_float(w & 0xffff0000u); }
__device__ __forceinline__ float sigmoidf_(float v) { return __builtin_amdgcn_rcpf(1.0f + __builtin_amdgcn_exp2f(-1.4426950408889634f * v)); }
__device__ __forceinline__ float gelu_tanh(float y) { const float u = 1.5957691216057308f * (y + 0.044715f * y * y * y); return y * sigmoidf_(u); }
template <int K> __device__ __forceinline__ float shx(float v) {
    return __uint_as_float((unsigned)__builtin_amdgcn_ds_swizzle((int)__float_as_uint(v), (K << 10) | 0x1f));
}
__device__ __forceinline__ float sum_x32(float v) { auto rr = __builtin_amdgcn_permlane32_swap(__float_as_uint(v), __float_as_uint(v), false, false); return __uint_as_float(rr[0]) + __uint_as_float(rr[1]); }
__device__ __forceinline__ float max_x32(float v) { auto rr = __builtin_amdgcn_permlane32_swap(__float_as_uint(v), __float_as_uint(v), false, false); return fmaxf(__uint_as_float(rr[0]), __uint_as_float(rr[1])); }
__device__ __forceinline__ float wave_sum(float v) {
    v += shx<1>(v); v += shx<2>(v); v += shx<4>(v); v += shx<8>(v); v += shx<16>(v); return sum_x32(v);
}
__device__ __forceinline__ float wave_max(float v) {
    v = fmaxf(v, shx<1>(v)); v = fmaxf(v, shx<2>(v)); v = fmaxf(v, shx<4>(v)); v = fmaxf(v, shx<8>(v)); v = fmaxf(v, shx<16>(v)); return max_x32(v);
}

namespace pg8 {
constexpr int BM = 256, BK = 64, HALF = 128, HTB = HALF * BK * 2, STAGE_BYTES = 8 * HTB, WGM = 4;
__host__ __device__ __forceinline__ int lds_byte(int r, int c) { const int st = (r >> 4) * 2 + (c >> 5), rr = r & 15, cc = c & 31, ob = rr * 64 + cc * 2; return st * 1024 + (ob ^ (((ob >> 9) & 1) << 5)); }
__host__ __device__ __forceinline__ void stage_rc(int b, int& R, int& C) { const int st = b / 1024, sb = b % 1024, swz = sb ^ (((sb >> 9) & 1) << 5); R = (st >> 1) * 16 + swz / 64; C = (st & 1) * 32 + (swz % 64) / 2; }

struct Unit { const bf16_t* A; const bf16_t* B; int nt; int pm; int pn; int mode; };

__device__ __forceinline__ bool tile_of(int L, int nM, int nN, int& pm, int& pn) {
    const int nwg = nM * nN; if (L >= nwg) return false;
    int wgid = (int)L; { const int q = nwg / 8, r = nwg % 8, xcd = wgid % 8, off = wgid / 8; wgid = (xcd < r ? xcd * (q + 1) : r * (q + 1) + (xcd - r) * q) + off; }
    const int nig = WGM * nN, gid = wgid / nig, fm = gid * WGM, gsz = (nM - fm) < WGM ? (nM - fm) : WGM;
    pm = fm + ((wgid % nig) % gsz); pn = (wgid % nig) / gsz; return true;
}

template <class Epi, class Sched, bool ALIGN_EPI, bool SP2, bool PERMA = false>
__device__ __forceinline__ void gemm_phase(LAS unsigned char* lds, const int tid, const int lda, const int ldb, const Sched& S, const Epi& E) {
    const int wid = __builtin_amdgcn_readfirstlane(tid >> 6), lane = tid & 63, wr = wid >> 2, wc = wid & 3, fr = lane & 15, fq = lane >> 4;
    unsigned voffA[2], voffB[2];
#pragma unroll
    for (int i = 0; i < 2; ++i) { int R, C; stage_rc(tid * 16 + i * 8192, R, C);
        const int Ra = PERMA ? (128 * (R >> 6) + 8 * (R & 15) + ((R >> 4) & 3)) : R;
        voffA[i] = (unsigned)(Ra * lda + C) * 2u; voffB[i] = (unsigned)(R * ldb + C) * 2u; }
    const size_t kstep = (size_t)(BK * 2);
    const size_t hsA = (size_t)(PERMA ? 4 : HALF) * lda * 2, hsB = (size_t)HALF * ldb * 2;
    const unsigned ldsw = (unsigned)wid * 1024u;
    const int aoff = lds_byte(wr * 64 + fr, fq * 8), boff = lds_byte(wc * 32 + fr, fq * 8);
#define PG8_SA(b, h) (((b) * 2 + (h)) * HTB)
#define PG8_SB(b, h) ((4 + (b) * 2 + (h)) * HTB)
#define PG8_STAGE(bufoff, gbase, voff) do { _Pragma("unroll") for (int _i = 0; _i < 2; ++_i) \
        __builtin_amdgcn_global_load_lds((const unsigned*)((const char*)(gbase) + (voff)[_i]), (LAS unsigned*)(lds + (bufoff) + ldsw + _i * 8192), 16, 0, 0); } while (0)
#define PG8_LDA(dst, b, h) do { _Pragma("unroll") for (int m = 0; m < 4; ++m) _Pragma("unroll") for (int k = 0; k < 2; ++k) dst[m][k] = *(const LAS bf16x8*)(lds + PG8_SA(b, h) + aoff + m * 2048 + k * 1024); } while (0)
#define PG8_LDB(dst, b, h) do { _Pragma("unroll") for (int n = 0; n < 2; ++n) _Pragma("unroll") for (int k = 0; k < 2; ++k) dst[n][k] = *(const LAS bf16x8*)(lds + PG8_SB(b, h) + boff + n * 2048 + k * 1024); } while (0)
#define PG8_MMA(ai, bj, At, Bt) do { __builtin_amdgcn_s_setprio(1); _Pragma("unroll") for (int m = 0; m < 4; ++m) _Pragma("unroll") for (int n = 0; n < 2; ++n) _Pragma("unroll") for (int k = 0; k < 2; ++k) \
        acc[ai][bj][m][n] = __builtin_amdgcn_mfma_f32_16x16x32_bf16(Bt[n][k], At[m][k], acc[ai][bj][m][n], 0, 0, 0); __builtin_amdgcn_s_setprio(0); } while (0)
#define PG8_WAIT_V(n) asm volatile("s_waitcnt vmcnt(" #n ")" ::: "memory")
#define PG8_WAIT_L(n) asm volatile("s_waitcnt lgkmcnt(" #n ")" ::: "memory")
#define PG8_BAR __builtin_amdgcn_s_barrier()
#define PG8_SCHED __builtin_amdgcn_sched_barrier(0)
    Unit cur, nxt; int ui = 0;
    if (!S.next(0, cur)) return;
    f32x4 acc[2][2][4][2];
#pragma unroll
    for (int a = 0; a < 2; ++a)
#pragma unroll
        for (int b = 0; b < 2; ++b)
#pragma unroll
            for (int m = 0; m < 4; ++m)
#pragma unroll
                for (int n = 0; n < 2; ++n) acc[a][b][m][n] = (f32x4){0.f, 0.f, 0.f, 0.f};
    bf16x8 At[4][2], B0[2][2], B1[2][2];
    const char* cA = (const char*)cur.A; const char* cB = (const char*)cur.B;
    if constexpr (SP2) {
        PG8_STAGE(PG8_SB(0, 0), cB, voffB); PG8_STAGE(PG8_SB(0, 1), cB + hsB, voffB); PG8_STAGE(PG8_SA(0, 0), cA, voffA); PG8_STAGE(PG8_SA(0, 1), cA + hsA, voffA);
        if (wr == 1) PG8_BAR;
        PG8_WAIT_V(2); PG8_BAR;
        PG8_STAGE(PG8_SB(1, 0), cB + kstep, voffB); PG8_STAGE(PG8_SA(1, 0), cA + kstep, voffA); PG8_STAGE(PG8_SB(1, 1), cB + hsB + kstep, voffB);
        PG8_WAIT_V(6); PG8_BAR;
    } else {
        PG8_STAGE(PG8_SB(0, 0), cB, voffB); PG8_STAGE(PG8_SA(0, 0), cA, voffA); PG8_STAGE(PG8_SB(0, 1), cB + hsB, voffB); PG8_STAGE(PG8_SA(0, 1), cA + hsA, voffA);
        if (wr == 1) PG8_BAR;
        PG8_WAIT_V(4); PG8_BAR;
        PG8_STAGE(PG8_SB(1, 0), cB + kstep, voffB); PG8_STAGE(PG8_SA(1, 0), cA + kstep, voffA); PG8_STAGE(PG8_SB(1, 1), cB + hsB + kstep, voffB);
        PG8_WAIT_V(6); PG8_BAR;
    }
    for (;;) {
        const bool has_next = S.next(ui + 1, nxt);
        const char* nA = has_next ? (const char*)nxt.A : cA; const char* nB = has_next ? (const char*)nxt.B : cB;
        const int nt = cur.nt;
        for (int t = 0; t < nt; t += 2) {
            const bool last = (t == nt - 2);
            const char* a1 = cA + (size_t)(t + 1) * kstep;
            const char* a2 = last ? nA : cA + (size_t)(t + 2) * kstep; const char* b2 = last ? nB : cB + (size_t)(t + 2) * kstep;
            const char* a3 = a2 + kstep; const char* b3 = b2 + kstep;
            if constexpr (SP2) {
            PG8_LDB(B0, 0, 0); PG8_LDB(B1, 0, 1); PG8_SCHED; PG8_LDA(At, 0, 0); PG8_STAGE(PG8_SA(1, 1), a1 + hsA, voffA);
            PG8_WAIT_V(8); PG8_WAIT_L(0); PG8_BAR; PG8_MMA(0, 0, At, B0); PG8_MMA(0, 1, At, B1); PG8_BAR; PG8_SCHED;
            PG8_LDA(At, 0, 1); PG8_STAGE(PG8_SB(0, 0), b2, voffB); PG8_STAGE(PG8_SB(0, 1), b2 + hsB, voffB); PG8_STAGE(PG8_SA(0, 0), a2, voffA);
            PG8_WAIT_V(8); PG8_WAIT_L(0); PG8_BAR; PG8_MMA(1, 0, At, B0); PG8_MMA(1, 1, At, B1); PG8_BAR; PG8_SCHED;
            PG8_LDB(B0, 1, 0); PG8_LDB(B1, 1, 1); PG8_SCHED; PG8_LDA(At, 1, 0); PG8_STAGE(PG8_SA(0, 1), a2 + hsA, voffA);
            PG8_WAIT_V(8); PG8_WAIT_L(0); PG8_BAR; PG8_MMA(0, 0, At, B0); PG8_MMA(0, 1, At, B1); PG8_BAR; PG8_SCHED;
            PG8_LDA(At, 1, 1); PG8_STAGE(PG8_SB(1, 0), b3, voffB); PG8_STAGE(PG8_SB(1, 1), b3 + hsB, voffB); PG8_STAGE(PG8_SA(1, 0), a3, voffA);
            PG8_WAIT_V(8); PG8_WAIT_L(0); PG8_BAR; PG8_MMA(1, 0, At, B0); PG8_MMA(1, 1, At, B1); PG8_BAR; PG8_SCHED;
            } else {
            PG8_LDB(B0, 0, 0); PG8_SCHED; PG8_LDA(At, 0, 0); PG8_STAGE(PG8_SA(1, 1), a1 + hsA, voffA);
            PG8_WAIT_L(8); PG8_BAR; PG8_WAIT_L(0); PG8_MMA(0, 0, At, B0); PG8_BAR; PG8_SCHED;
            PG8_LDB(B1, 0, 1); PG8_STAGE(PG8_SB(0, 0), b2, voffB);
            PG8_BAR; PG8_WAIT_L(0); PG8_MMA(0, 1, At, B1); PG8_BAR;
            PG8_LDA(At, 0, 1); PG8_STAGE(PG8_SA(0, 0), a2, voffA);
            PG8_BAR; PG8_WAIT_L(0); PG8_MMA(1, 0, At, B0); PG8_BAR; PG8_SCHED;
            PG8_STAGE(PG8_SB(0, 1), b2 + hsB, voffB);
            PG8_WAIT_V(6); PG8_BAR; PG8_MMA(1, 1, At, B1); PG8_BAR;
            PG8_LDB(B0, 1, 0); PG8_SCHED; PG8_LDA(At, 1, 0); PG8_STAGE(PG8_SA(0, 1), a2 + hsA, voffA);
            PG8_WAIT_L(8); PG8_BAR; PG8_WAIT_L(0); PG8_MMA(0, 0, At, B0); PG8_BAR; PG8_SCHED;
            PG8_LDB(B1, 1, 1); PG8_STAGE(PG8_SB(1, 0), b3, voffB);
            PG8_BAR; PG8_WAIT_L(0); PG8_MMA(0, 1, At, B1); PG8_BAR;
            PG8_LDA(At, 1, 1); PG8_STAGE(PG8_SA(1, 0), a3, voffA);
            PG8_BAR; PG8_WAIT_L(0); PG8_MMA(1, 0, At, B0); PG8_BAR; PG8_SCHED;
            PG8_STAGE(PG8_SB(1, 1), b3 + hsB, voffB);
            PG8_WAIT_V(6); PG8_BAR; PG8_MMA(1, 1, At, B1); PG8_BAR;
            }
        }
        if constexpr (ALIGN_EPI) { if (wr == 0) PG8_BAR; }
        { int frl = fr, fql = fq; asm volatile("" : "+v"(frl), "+v"(fql)); E(acc, cur, wr, wc, frl, fql); }
        if (!has_next) break;
#pragma unroll
        for (int a = 0; a < 2; ++a)
#pragma unroll
            for (int b = 0; b < 2; ++b)
#pragma unroll
                for (int m = 0; m < 4; ++m)
#pragma unroll
                    for (int n = 0; n < 2; ++n) acc[a][b][m][n] = (f32x4){0.f, 0.f, 0.f, 0.f};
        cur = nxt; cA = nA; cB = nB; ++ui;
        if constexpr (ALIGN_EPI) { if (wr == 1) PG8_BAR; }
    }
    PG8_WAIT_V(0);
    if constexpr (!ALIGN_EPI) { if (wr == 0) PG8_BAR; }
    PG8_BAR;
#undef PG8_SA
#undef PG8_SB
#undef PG8_STAGE
#undef PG8_LDA
#undef PG8_LDB
#undef PG8_MMA
#undef PG8_WAIT_V
#undef PG8_WAIT_L
#undef PG8_BAR
#undef PG8_SCHED
}
}
using pg8::Unit;

struct SchedPlain {
    const bf16_t* A; const bf16_t* B; int lda, ldb, nM, nN, nt, G, c, pm0;
    __device__ __forceinline__ bool next(int i, Unit& u) const {
        int pm, pn; if (!pg8::tile_of(i * G + c, nM, nN, pm, pn)) return false;
        u.A = A + (size_t)pm * 256 * lda; u.B = B + (size_t)pn * 256 * ldb; u.nt = nt; u.pm = pm0 + pm; u.pn = pn; u.mode = 0; return true;
    }
};
struct SchedS5 {
    const bf16_t* UC; const bf16_t* B; int ldb, nN, nt, G, c, nmt;
    __device__ __forceinline__ bool next(int i, Unit& u) const {
        const int L = i * G + c; if (L >= 32 * nmt * nN) return false;
        const int pn = L % nN, mt = (L / nN) % nmt, g = L / (nmt * nN);
        u.A = UC + ((size_t)g * CHPAD + 256 * mt) * 768; u.B = B + ((size_t)g * nN * 256 + (size_t)pn * 256) * ldb; u.nt = nt; u.pm = mt; u.pn = pn; u.mode = g; return true;
    }
};
struct SchedMerge {
    const bf16_t* H; const bf16_t* YAB; const bf16_t* YD; const bf16_t* Bcat; int nchain, G, c;
    __device__ __forceinline__ bool next(int i, Unit& u) const {
        const int nl = (c < 512) ? (512 - c + G - 1) / G : 0;
        int pm, pn, j, sub;
        if (i < 6 * nl) { const int ti = i / 6; sub = i - ti * 6; j = sub >> 1; pg8::tile_of(ti * G + c, 128, 4, pm, pn); u.mode = sub; }
        else { const int k = i - 6 * nl; if (k >= 2 || c >= nchain) return false;
               const int tile = c / 3; j = c - tile * 3; pm = 128 + (tile >> 2); pn = tile & 3; sub = k; u.mode = 8 + 2 * j + k; }
        const bf16_t* Bj = Bcat + (size_t)j * 1024 * 1536 + (size_t)pn * 256 * 1536;
        if ((sub & 1) == 0) { u.A = H + (size_t)pm * 256 * 1024; u.B = Bj; u.nt = 16; }
        else { const bf16_t* Y = (j == 0) ? YAB : (j == 1) ? (YAB + 512) : YD; u.A = Y + (size_t)pm * 256 * 1024; u.B = Bj + 1024; u.nt = 8; }
        u.pm = pm; u.pn = pn; return true;
    }
};
struct SchedG4 {
    const bf16_t* M; const bf16_t* MCTX; const bf16_t* B; int nchain, G, c;
    __device__ __forceinline__ bool next(int i, Unit& u) const {
        const int L = i * G + c;
        if (L < 512) { int pm, pn; pg8::tile_of(L, 128, 4, pm, pn); u.A = M + (size_t)pm * 256 * 1024; u.B = B + (size_t)pn * 256 * 1024; u.nt = 16; u.pm = pm; u.pn = pn; u.mode = 0; return true; }
        const int p = L - 512; if (p >= nchain) return false;
        const int tile = p / 3, j = p - tile * 3, pm = 128 + (tile >> 2), pn = tile & 3;
        u.A = MCTX + (size_t)j * NCTX * 1024 + (size_t)(pm - 128) * 256 * 1024; u.B = B + (size_t)pn * 256 * 1024; u.nt = 16; u.pm = pm; u.pn = pn; u.mode = 1 + j; return true;
    }
};
struct SchedG6c {
    const bf16_t* A; const bf16_t* B; int G, c, nparts;
    __device__ __forceinline__ bool next(int i, Unit& u) const {
        const int L = i * G + c;
        if (L < 512) { int pm, pn; pg8::tile_of(L, 128, 4, pm, pn); u.A = A + (size_t)pm * 256 * 2816; u.B = B + (size_t)pn * 256 * 2816; u.nt = 44; u.pm = pm; u.pn = pn; u.mode = 0; return true; }
        if (L >= 512 + nparts) return false;
        const int p = L - 512, tile = p >> 2, kp = p & 3, pm = 128 + (tile >> 2), pn = tile & 3, koff = (kp < 2) ? kp * 768 : 1536 + (kp - 2) * 640;
        u.A = A + (size_t)pm * 256 * 2816 + koff; u.B = B + (size_t)pn * 256 * 2816 + koff; u.nt = (kp < 2) ? 12 : 10; u.pm = pm; u.pn = pn; u.mode = 1 + kp; return true;
    }
};

#define FOR_AI_M _Pragma("unroll") for (int ai = 0; ai < 2; ++ai) _Pragma("unroll") for (int m = 0; m < 4; ++m)

struct EpiG1 {
    bf16_t *YAB, *YD, *KA, *VA, *KC, *VC, *UC; const float* qkg; const float* tab;
    __device__ __forceinline__ void operator()(const f32x4 (&acc)[2][2][4][2], const Unit& u, int wr, int wc, int fr, int fq) const {
        const int pn = u.pn; const bool isctx = u.pm >= 128;
        int kind; bf16_t* dst = nullptr; int pitch = 0, colbase = 0; const float* gain = qkg;
        if (pn < 2) { kind = 0; dst = YAB; pitch = 1024; colbase = 256 * pn + 64 * wc; gain = qkg; }
        else if (pn == 2) { if (wc < 2) { kind = 1; dst = KA; pitch = 128; colbase = 64 * wc; gain = qkg + 64; } else { kind = 2; dst = VA; pitch = 128; colbase = 64 * (wc - 2); } }
        else if (pn < 5) { kind = 3; }
        else if (pn < 7) { kind = 0; dst = YD; pitch = 1024; colbase = 256 * (pn - 5) + 64 * wc; gain = qkg + 128; }
        else if (pn < 9) { kind = 1; dst = KC; pitch = 512; colbase = 256 * (pn - 7) + 64 * wc; gain = qkg + 192; }
        else { kind = 2; dst = VC; pitch = 512; colbase = 256 * (pn - 9) + 64 * wc; }
        if (kind <= 1) {
            f32x4 g[2][2];
#pragma unroll
            for (int bj = 0; bj < 2; ++bj)
#pragma unroll
                for (int n = 0; n < 2; ++n) g[bj][n] = *(const f32x4*)(gain + 32 * bj + 8 * fq + 4 * n);
            const float qs = (kind == 0) ? QSCALE : 1.0f;
            FOR_AI_M {
                const int row = 256 * u.pm + 128 * ai + 64 * wr + 16 * m + fr;
                f32x4 x[2][2]; float ss = 0.f;
#pragma unroll
                for (int bj = 0; bj < 2; ++bj)
#pragma unroll
                    for (int n = 0; n < 2; ++n) { x[bj][n] = acc[ai][bj][m][n]; ss += (x[bj][n][0] * x[bj][n][0] + x[bj][n][1] * x[bj][n][1]) + (x[bj][n][2] * x[bj][n][2] + x[bj][n][3] * x[bj][n][3]); }
                ss += shx<16>(ss); ss = sum_x32(ss);
                const float rinv = rsqrtf(ss * (1.0f / 64.0f) + EPS);
#pragma unroll
                for (int bj = 0; bj < 2; ++bj)
#pragma unroll
                    for (int n = 0; n < 2; ++n) x[bj][n] = x[bj][n] * rinv * g[bj][n];
                if (!isctx) {
                    const int t = row & (SEQ - 1); const int p = (fq < 2) ? (t >> 6) : (t & 63);
                    const float* tp = tab + (p * 16 + 8 * (fq & 1)) * 2;
#pragma unroll
                    for (int n = 0; n < 2; ++n) {
                        const f32x4 cs0 = *(const f32x4*)(tp + 8 * n), cs1 = *(const f32x4*)(tp + 8 * n + 4);
                        const float c[4] = {cs0[0], cs0[2], cs1[0], cs1[2]}, s[4] = {cs0[1], cs0[3], cs1[1], cs1[3]};
#pragma unroll
                        for (int e = 0; e < 4; ++e) { const float lo = x[0][n][e], hi = x[1][n][e]; x[0][n][e] = lo * c[e] - hi * s[e]; x[1][n][e] = hi * c[e] + lo * s[e]; }
                    }
                }
#pragma unroll
                for (int bj = 0; bj < 2; ++bj) {
                    u32x4 w; w.x = cvt_pk_bf16(x[bj][0][0] * qs, x[bj][0][1] * qs); w.y = cvt_pk_bf16(x[bj][0][2] * qs, x[bj][0][3] * qs);
                    w.z = cvt_pk_bf16(x[bj][1][0] * qs, x[bj][1][1] * qs); w.w = cvt_pk_bf16(x[bj][1][2] * qs, x[bj][1][3] * qs);
                    *(u32x4*)(dst + (size_t)row * pitch + colbase + 32 * bj + 8 * fq) = w;
                }
            }
        } else if (kind == 2) {
            FOR_AI_M {
                const int row = 256 * u.pm + 128 * ai + 64 * wr + 16 * m + fr;
#pragma unroll
                for (int bj = 0; bj < 2; ++bj) {
                    const f32x4 a = acc[ai][bj][m][0], b = acc[ai][bj][m][1];
                    u32x4 w; w.x = cvt_pk_bf16(a[0], a[1]); w.y = cvt_pk_bf16(a[2], a[3]); w.z = cvt_pk_bf16(b[0], b[1]); w.w = cvt_pk_bf16(b[2], b[3]);
                    *(u32x4*)(dst + (size_t)row * pitch + colbase + 32 * bj + 8 * fq) = w;
                }
            }
        } else {
            FOR_AI_M {
                const int row = 256 * u.pm + 128 * ai + 64 * wr + 16 * m + fr;
#pragma unroll
                for (int bj = 0; bj < 2; ++bj) {
                    const int g = 16 * (pn - 3) + 4 * wc + 2 * bj + (fq >> 1);
                    const f32x4 a = acc[ai][bj][m][0], b = acc[ai][bj][m][1];
                    u32x4 w; w.x = cvt_pk_bf16(a[0], a[1]); w.y = cvt_pk_bf16(a[2], a[3]); w.z = cvt_pk_bf16(b[0], b[1]); w.w = cvt_pk_bf16(b[2], b[3]);
                    *(u32x4*)(UC + ((size_t)g * CHPAD + (row >> 5)) * 768 + (row & 31) * 16 + 8 * (fq & 1)) = w;
                }
            }
        }
    }
};

struct EpiS {
    float* S;
    __device__ __forceinline__ void operator()(const f32x4 (&acc)[2][2][4][2], const Unit& u, int wr, int wc, int fr, int fq) const {
        FOR_AI_M {
            const int chunk = 256 * u.pm + 128 * ai + 64 * wr + 16 * m + fr;
            float* rp = S + ((size_t)u.mode * CHPAD + chunk) * 256 + 32 * wc + 4 * fq;
#pragma unroll
            for (int bj = 0; bj < 2; ++bj)
#pragma unroll
                for (int n = 0; n < 2; ++n) *(f32x4*)(rp + 128 * bj + 16 * n) = acc[ai][bj][m][n];
        }
    }
};

struct EpiY {
    bf16_t* GACT;
    __device__ __forceinline__ void operator()(const f32x4 (&acc)[2][2][4][2], const Unit& u, int wr, int wc, int fr, int fq) const {
        FOR_AI_M {
            const int chunk = 256 * u.pm + 128 * ai + 64 * wr + 16 * m + fr;
            if (chunk < NCHUNK) {
#pragma unroll
                for (int bj = 0; bj < 2; ++bj)
#pragma unroll
                    for (int n = 0; n < 2; ++n) {
                        const int tl = 16 * u.pn + 8 * bj + 2 * wc + n; const size_t row = (size_t)chunk * 32 + tl;
                        const f32x4 v = acc[ai][bj][m][n];
                        u32x2 w; w.x = cvt_pk_bf16(gelu_tanh(v[0]), gelu_tanh(v[1])); w.y = cvt_pk_bf16(gelu_tanh(v[2]), gelu_tanh(v[3]));
                        *(u32x2*)(GACT + row * 1024 + 16 * u.mode + 4 * fq) = w;
                    }
            }
        }
    }
};

struct EpiGLU {
    const bf16_t* GACT; bf16_t* YB; const float* bglu;
    __device__ __forceinline__ void operator()(const f32x4 (&acc)[2][2][4][2], const Unit& u, int wr, int wc, int fr, int fq) const {
        f32x4 bv[2][2];
#pragma unroll
        for (int bj = 0; bj < 2; ++bj)
#pragma unroll
            for (int n = 0; n < 2; ++n) bv[bj][n] = *(const f32x4*)(bglu + 256 * u.pn + 128 * bj + 32 * wc + 8 * fq + 4 * n);
        const size_t col0 = (size_t)256 * u.pn + 32 * wc + 8 * fq;
        u32x4 gpre[2][2];
#pragma unroll
        for (int bj = 0; bj < 2; ++bj) gpre[0][bj] = *(const u32x4*)(GACT + ((size_t)256 * u.pm + 64 * wr + fr) * 1024 + col0 + 128 * bj);
#pragma unroll
        for (int g = 0; g < 8; ++g) {
            const int ai = g >> 2, m = g & 3;
            const size_t row = (size_t)256 * u.pm + 128 * ai + 64 * wr + 16 * m + fr;
            if (g + 1 < 8) {
                const size_t rn = (size_t)256 * u.pm + 128 * ((g + 1) >> 2) + 64 * wr + 16 * ((g + 1) & 3) + fr;
#pragma unroll
                for (int bj = 0; bj < 2; ++bj) gpre[(g + 1) & 1][bj] = *(const u32x4*)(GACT + rn * 1024 + col0 + 128 * bj);
            }
            asm volatile("" ::: "memory");
#pragma unroll
            for (int bj = 0; bj < 2; ++bj) {
                const u32x4 gv = gpre[g & 1][bj];
                const f32x4 a = acc[ai][bj][m][0] + bv[bj][0], b = acc[ai][bj][m][1] + bv[bj][1];
                u32x4 w;
                w.x = cvt_pk_bf16(bflo(gv.x) * sigmoidf_(a[0]), bfhi(gv.x) * sigmoidf_(a[1])); w.y = cvt_pk_bf16(bflo(gv.y) * sigmoidf_(a[2]), bfhi(gv.y) * sigmoidf_(a[3]));
                w.z = cvt_pk_bf16(bflo(gv.z) * sigmoidf_(b[0]), bfhi(gv.z) * sigmoidf_(b[1])); w.w = cvt_pk_bf16(bflo(gv.w) * sigmoidf_(b[2]), bfhi(gv.w) * sigmoidf_(b[3]));
                *(u32x4*)(YB + row * 1024 + col0 + 128 * bj) = w;
            }
        }
    }
};

struct EpiMerge {
    bf16_t* M; float* stm; unsigned* stg; int tid_; bf16_t* MCTX;
    __device__ __forceinline__ void operator()(const f32x4 (&acc)[2][2][4][2], const Unit& u, int wr, int wc, int fr, int fq) const {
        const int sub = u.mode, tid = (wr * 4 + wc) * 64 + fq * 16 + fr;
        if ((sub & 1) == 0) {
            FOR_AI_M {
#pragma unroll
                for (int bj = 0; bj < 2; ++bj) {
                    const int i0 = (((ai * 2 + bj) * 4 + m) * 2) * 512 + tid, i1 = i0 + 512;
                    const f32x4 a = acc[ai][bj][m][0], b = acc[ai][bj][m][1];
                    u32x2 w0, w1; w0.x = cvt_pk_bf16(sigmoidf_(a[0]), sigmoidf_(a[1])); w0.y = cvt_pk_bf16(sigmoidf_(a[2]), sigmoidf_(a[3]));
                    w1.x = cvt_pk_bf16(sigmoidf_(b[0]), sigmoidf_(b[1])); w1.y = cvt_pk_bf16(sigmoidf_(b[2]), sigmoidf_(b[3]));
                    *(u32x2*)(stg + (size_t)i0 * 2) = w0; *(u32x2*)(stg + (size_t)i1 * 2) = w1;
                }
                asm volatile("" ::: "memory");
            }
            return;
        }
        const bool iso = sub >= 8, addm = (sub > 1) && !iso;
        u32x2 gp[2][2][2]; f32x4 mp[2][2][2];
#pragma unroll
        for (int bj = 0; bj < 2; ++bj) {
            const int i0 = ((bj * 4) * 2) * 512 + tid, i1 = i0 + 512;
            gp[0][bj][0] = *(const u32x2*)(stg + (size_t)i0 * 2); gp[0][bj][1] = *(const u32x2*)(stg + (size_t)i1 * 2);
            if (addm) { mp[0][bj][0] = *(const f32x4*)(stm + (size_t)i0 * 4); mp[0][bj][1] = *(const f32x4*)(stm + (size_t)i1 * 4); }
        }
#pragma unroll
        for (int g = 0; g < 8; ++g) {
            const int ai = g >> 2, m = g & 3;
            const size_t row = (size_t)256 * u.pm + 128 * ai + 64 * wr + 16 * m + fr;
            if (g + 1 < 8) {
                const int an = (g + 1) >> 2, mn = (g + 1) & 3;
#pragma unroll
                for (int bj = 0; bj < 2; ++bj) {
                    const int i0 = (((an * 2 + bj) * 4 + mn) * 2) * 512 + tid, i1 = i0 + 512;
                    gp[(g + 1) & 1][bj][0] = *(const u32x2*)(stg + (size_t)i0 * 2); gp[(g + 1) & 1][bj][1] = *(const u32x2*)(stg + (size_t)i1 * 2);
                    if (addm) { mp[(g + 1) & 1][bj][0] = *(const f32x4*)(stm + (size_t)i0 * 4); mp[(g + 1) & 1][bj][1] = *(const f32x4*)(stm + (size_t)i1 * 4); }
                }
            }
            asm volatile("" ::: "memory");
#pragma unroll
            for (int bj = 0; bj < 2; ++bj) {
                const int i0 = (((ai * 2 + bj) * 4 + m) * 2) * 512 + tid, i1 = i0 + 512;
                const u32x2 g0 = gp[g & 1][bj][0], g1 = gp[g & 1][bj][1];
                f32x4 a = acc[ai][bj][m][0], b = acc[ai][bj][m][1];
                a = a * (f32x4){bflo(g0.x), bfhi(g0.x), bflo(g0.y), bfhi(g0.y)}; b = b * (f32x4){bflo(g1.x), bfhi(g1.x), bflo(g1.y), bfhi(g1.y)};
                if (addm) { a += mp[g & 1][bj][0]; b += mp[g & 1][bj][1]; }
                if (sub < 5) { *(f32x4*)(stm + (size_t)i0 * 4) = a; *(f32x4*)(stm + (size_t)i1 * 4) = b; }
                else {
                    u32x4 w; w.x = cvt_pk_bf16(a[0], a[1]); w.y = cvt_pk_bf16(a[2], a[3]); w.z = cvt_pk_bf16(b[0], b[1]); w.w = cvt_pk_bf16(b[2], b[3]);
                    bf16_t* dst = iso ? MCTX + (size_t)((sub - 8) >> 1) * NCTX * 1024 + (row - NLAT) * 1024 : M + row * 1024;
                    *(u32x4*)(dst + 256 * u.pn + 128 * bj + 32 * wc + 8 * fq) = w;
                }
            }
        }
    }
};

struct EpiRes {
    const float* base_lat; const float* base_ctx; float* out_lat; float* out_ctx; const float* mod; int moff; float* part;
    __device__ __forceinline__ void operator()(const f32x4 (&acc)[2][2][4][2], const Unit& u, int wr, int wc, int fr, int fq) const {
        const int row0 = 256 * u.pm; const bool isctx = row0 >= NLAT; const int mb = isctx ? 4 : (row0 >> 13);
        const float* bp = isctx ? base_ctx + (size_t)(row0 - NLAT) * 1024 : base_lat + (size_t)row0 * 1024;
        float* op = isctx ? out_ctx + (size_t)(row0 - NLAT) * 1024 : out_lat + (size_t)row0 * 1024;
        const float* mp = mod + mb * 6144 + moff;
        f32x4 mv[2][2];
#pragma unroll
        for (int bj = 0; bj < 2; ++bj)
#pragma unroll
            for (int n = 0; n < 2; ++n) mv[bj][n] = *(const f32x4*)(mp + 256 * u.pn + 128 * bj + 32 * wc + 8 * fq + 4 * n);
        const size_t cb0 = (size_t)256 * u.pn + 32 * wc + 8 * fq;
        if (u.mode > 0) {
            float* pp = part + (size_t)(u.mode - 1) * NCTX * 1024 + (size_t)(row0 - NLAT) * 1024;
            FOR_AI_M {
                const size_t ro = (size_t)(128 * ai + 64 * wr + 16 * m + fr) * 1024 + cb0;
#pragma unroll
                for (int bj = 0; bj < 2; ++bj)
#pragma unroll
                    for (int n = 0; n < 2; ++n) *(f32x4*)(pp + ro + 128 * bj + 4 * n) = mv[bj][n] * acc[ai][bj][m][n];
            }
            return;
        }
        f32x4 pre[2][2][2];
#pragma unroll
        for (int bj = 0; bj < 2; ++bj)
#pragma unroll
            for (int n = 0; n < 2; ++n) pre[0][bj][n] = *(const f32x4*)(bp + (size_t)(64 * wr + fr) * 1024 + cb0 + 128 * bj + 4 * n);
#pragma unroll
        for (int g = 0; g < 8; ++g) {
            const int ai = g >> 2, m = g & 3;
            const size_t ro = (size_t)(128 * ai + 64 * wr + 16 * m + fr) * 1024 + cb0;
            if (g + 1 < 8) {
                const size_t rn = (size_t)(128 * ((g + 1) >> 2) + 64 * wr + 16 * ((g + 1) & 3) + fr) * 1024 + cb0;
#pragma unroll
                for (int bj = 0; bj < 2; ++bj)
#pragma unroll
                    for (int n = 0; n < 2; ++n) pre[(g + 1) & 1][bj][n] = *(const f32x4*)(bp + rn + 128 * bj + 4 * n);
            }
            asm volatile("" ::: "memory");
#pragma unroll
            for (int bj = 0; bj < 2; ++bj)
#pragma unroll
                for (int n = 0; n < 2; ++n) *(f32x4*)(op + ro + 128 * bj + 4 * n) = pre[g & 1][bj][n] + mv[bj][n] * acc[ai][bj][m][n];
        }
    }
};

__device__ __forceinline__ float dpp_shr1(float v) { return __builtin_bit_cast(float, __builtin_amdgcn_update_dpp(0, __builtin_bit_cast(int, v), 0x111, 0xf, 0xf, true)); }
__device__ __forceinline__ float dpp_shl1(float v) { return __builtin_bit_cast(float, __builtin_amdgcn_update_dpp(0, __builtin_bit_cast(int, v), 0x101, 0xf, 0xf, true)); }

struct SchedUp {
    const bf16_t* H; const bf16_t* HB; const bf16_t* B; int nM, G, c;
    __device__ __forceinline__ bool next(int i, Unit& u) const {
        const int L = i * G + c, nmain = nM * 22;
        if (L < nmain) { int pm, pn; pg8::tile_of(L, nM, 22, pm, pn); u.A = H + (size_t)pm * 256 * 1024; u.B = B + (size_t)pn * 256 * 1024; u.nt = 16; u.pm = pm; u.pn = pn; u.mode = 0; return true; }
        const int Lb = L - nmain; if (Lb >= 110) return false;
        const int mt = Lb / 22, pn = Lb - mt * 22;
        u.A = HB + (size_t)mt * 256 * 1024; u.B = B + (size_t)pn * 256 * 1024; u.nt = 16; u.pm = mt; u.pn = pn; u.mode = 1; return true;
    }
};

struct EpiUpConv {
    bf16_t* ACT; int nrows; const float* cw; const float* cb;
    __device__ __forceinline__ void operator()(const f32x4 (&acc)[2][2][4][2], const Unit& u, int wr, int wc, int fr, int fq) const {
        if (u.mode == 1) {
#pragma unroll
            for (int n = 0; n < 2; ++n) {
                const int f0 = 128 * u.pn + 32 * wc + 8 * fq + 4 * n;
                f32x4 wa[3], wg[3];
#pragma unroll
                for (int j = 0; j < 3; ++j) { wa[j] = *(const f32x4*)(cw + j * 5632 + f0); wg[j] = *(const f32x4*)(cw + j * 5632 + 2816 + f0); }
                const f32x4 ba = *(const f32x4*)(cb + f0), bg = *(const f32x4*)(cb + 2816 + f0);
#pragma unroll
                for (int ai = 0; ai < 2; ++ai) {
                    const int j = 64 * u.pm + 32 * wr + 2 * fr + ai;
                    const bool seqb = (j < 256) ? ((j & 63) == 0) : ((j & 1) == 0);
                    const f32x4 z4 = (f32x4){0.f, 0.f, 0.f, 0.f};
                    const int rowL = 128 * j - 1, rowR = 128 * j;
                    if (j >= 1 && j < NBGRP && rowL < nrows) {
                        const f32x4 ca = wa[0] * acc[ai][0][0][n] + wa[1] * acc[ai][0][1][n] + wa[2] * (seqb ? z4 : acc[ai][0][2][n]) + ba;
                        const f32x4 cg = wg[0] * acc[ai][1][0][n] + wg[1] * acc[ai][1][1][n] + wg[2] * (seqb ? z4 : acc[ai][1][2][n]) + bg;
                        u32x2 w; w.x = cvt_pk_bf16(cg[0] * sigmoidf_(cg[0]) * ca[0], cg[1] * sigmoidf_(cg[1]) * ca[1]); w.y = cvt_pk_bf16(cg[2] * sigmoidf_(cg[2]) * ca[2], cg[3] * sigmoidf_(cg[3]) * ca[3]);
                        *(u32x2*)(ACT + (size_t)rowL * 2816 + f0) = w;
                    }
                    if (j < NBGRP && rowR < nrows) {
                        const f32x4 ca = wa[0] * (seqb ? z4 : acc[ai][0][1][n]) + wa[1] * acc[ai][0][2][n] + wa[2] * acc[ai][0][3][n] + ba;
                        const f32x4 cg = wg[0] * (seqb ? z4 : acc[ai][1][1][n]) + wg[1] * acc[ai][1][2][n] + wg[2] * acc[ai][1][3][n] + bg;
                        u32x2 w; w.x = cvt_pk_bf16(cg[0] * sigmoidf_(cg[0]) * ca[0], cg[1] * sigmoidf_(cg[1]) * ca[1]); w.y = cvt_pk_bf16(cg[2] * sigmoidf_(cg[2]) * ca[2], cg[3] * sigmoidf_(cg[3]) * ca[3]);
                        *(u32x2*)(ACT + (size_t)rowR * 2816 + f0) = w;
                    }
                }
            }
            return;
        }
        const size_t row0 = (size_t)256 * u.pm + 128 * wr + 8 * fr;
#pragma unroll
        for (int n = 0; n < 2; ++n) {
            const int f0 = 128 * u.pn + 32 * wc + 8 * fq + 4 * n;
            f32x4 wa[3], wg[3];
#pragma unroll
            for (int j = 0; j < 3; ++j) { wa[j] = *(const f32x4*)(cw + j * 5632 + f0); wg[j] = *(const f32x4*)(cw + j * 5632 + 2816 + f0); }
            const f32x4 ba = *(const f32x4*)(cb + f0), bg = *(const f32x4*)(cb + 2816 + f0);
            f32x4 pa, pg, na, ng;
#pragma unroll
            for (int e = 0; e < 4; ++e) { pa[e] = dpp_shr1(acc[1][0][3][n][e]); pg[e] = dpp_shr1(acc[1][1][3][n][e]); na[e] = dpp_shl1(acc[0][0][0][n][e]); ng[e] = dpp_shl1(acc[0][1][0][n][e]); }
#pragma unroll
            for (int k = 0; k < 8; ++k) {
                const f32x4 ua0 = (k == 0) ? pa : acc[(k - 1) >> 2][0][(k - 1) & 3][n], ua1 = acc[k >> 2][0][k & 3][n], ua2 = (k == 7) ? na : acc[(k + 1) >> 2][0][(k + 1) & 3][n];
                const f32x4 ug0 = (k == 0) ? pg : acc[(k - 1) >> 2][1][(k - 1) & 3][n], ug1 = acc[k >> 2][1][k & 3][n], ug2 = (k == 7) ? ng : acc[(k + 1) >> 2][1][(k + 1) & 3][n];
                const f32x4 ca = wa[0] * ua0 + wa[1] * ua1 + wa[2] * ua2 + ba, cg = wg[0] * ug0 + wg[1] * ug1 + wg[2] * ug2 + bg;
                u32x2 w; w.x = cvt_pk_bf16(cg[0] * sigmoidf_(cg[0]) * ca[0], cg[1] * sigmoidf_(cg[1]) * ca[1]); w.y = cvt_pk_bf16(cg[2] * sigmoidf_(cg[2]) * ca[2], cg[3] * sigmoidf_(cg[3]) * ca[3]);
                const bool edge = (k == 0 && fr == 0) || (k == 7 && fr == 15);
                if (!edge) *(u32x2*)(ACT + (row0 + k) * 2816 + f0) = w;
            }
        }
    }
};

#define XB_TMO      128
#define XB_XCNT(j)  (256  + 64 * (j))
#define XB_XSUB(j)  (1280 + 64 * (j))
#define XB_XGEN(j)  (2304 + 64 * (j))
#define XB_TOP      3328
#define XB_TOPGEN   3392
#define XCD_BAR_WORDS 3456
#define XB_SPIN_CAP (1u << 22)
__device__ __forceinline__ unsigned xb_ld(unsigned* p)              { return __hip_atomic_load(p, __ATOMIC_RELAXED, __HIP_MEMORY_SCOPE_AGENT); }
__device__ __forceinline__ unsigned xb_add(unsigned* p, unsigned v) { return __hip_atomic_fetch_add(p, v, __ATOMIC_RELAXED, __HIP_MEMORY_SCOPE_AGENT); }
__device__ __forceinline__ unsigned xb_xcc_id() { return (unsigned)__builtin_amdgcn_s_getreg((3 << 11) | 20) & 0xFu; }
#define XB_SPIN(cond, bar) do { unsigned _sp = 0; while (cond) { __builtin_amdgcn_s_sleep(1); \
    if ((++_sp & 255u) == 0u) { if (xb_ld(&(bar)[XB_TMO])) break; if (_sp > XB_SPIN_CAP) { atomicAdd(&(bar)[XB_TMO], 1u); break; } } } } while (0)
struct XcdBarrier { unsigned* bar; unsigned x; volatile LAS unsigned* st; };
__device__ __forceinline__ XcdBarrier xcd_barrier_post(unsigned* bar, volatile LAS unsigned* st) {
    XcdBarrier b; b.bar = bar; b.x = xb_xcc_id(); b.st = st;
    if (threadIdx.x == 0) (void)xb_add(&bar[XB_XCNT(b.x)], 1u);
    return b;
}
__device__ __forceinline__ void xcd_barrier_complete(unsigned* bar, unsigned x, unsigned& nloc, unsigned& nx) {
    const unsigned G = gridDim.x * gridDim.y * gridDim.z;
    unsigned sum, cnt, mine, sp = 0u;
    for (;;) {
        sum = 0u; cnt = 0u; mine = 0u;
#pragma unroll
        for (unsigned j = 0; j < 16; ++j) { const unsigned c = xb_ld(&bar[XB_XCNT(j)]); sum += c; cnt += (c > 0u) ? 1u : 0u; mine = (j == x) ? c : mine; }
        if (sum == G) break;
        __builtin_amdgcn_s_sleep(1);
        if ((++sp & 255u) == 0u) { if (xb_ld(&bar[XB_TMO])) break; if (sp > XB_SPIN_CAP) { atomicAdd(&bar[XB_TMO], 1u); break; } }
    }
    nloc = mine > 0u ? mine : 1u; nx = cnt > 0u ? cnt : 1u;
}
__device__ __forceinline__ void xcd_barrier(const XcdBarrier& b) {
    asm volatile("s_waitcnt vmcnt(0)" ::: "memory");
    __syncthreads();
    if (threadIdx.x == 0) {
        unsigned* bar = b.bar;
        __builtin_amdgcn_s_waitcnt(0);
        unsigned nloc = b.st[0], nx = b.st[1];
        if (nloc == 0u) { xcd_barrier_complete(bar, b.x, nloc, nx); b.st[0] = nloc; b.st[1] = nx; }
        const unsigned old = xb_add(&bar[XB_XSUB(b.x)], 1u);
        const unsigned gen = old / nloc;
        if (old + 1u == (gen + 1u) * nloc) {
            __builtin_amdgcn_fence(__ATOMIC_RELEASE, "agent");
            asm volatile("s_waitcnt vmcnt(0)" ::: "memory");
            const unsigned og = xb_add(&bar[XB_TOP], 1u);
            const unsigned tg = og / nx;
            if (og + 1u == (tg + 1u) * nx) xb_add(&bar[XB_TOPGEN], 1u);
            else XB_SPIN(xb_ld(&bar[XB_TOPGEN]) == tg, bar);
            __builtin_amdgcn_fence(__ATOMIC_ACQUIRE, "agent");
            xb_add(&bar[XB_XGEN(b.x)], 1u);
            asm volatile("s_waitcnt vmcnt(0)" ::: "memory");
        } else {
            XB_SPIN(xb_ld(&bar[XB_XGEN(b.x)]) == gen, bar);
            __builtin_amdgcn_fence(__ATOMIC_ACQUIRE, "agent");
            asm volatile("s_waitcnt vmcnt(0)" ::: "memory");
        }
    }
    __syncthreads();
}

struct Frame {
    unsigned char* lds; int tid, lane, wave, G, bid;
};

__device__ __forceinline__ void transpose_item(const float* W, int ldw, int k0, int n0, bf16_t* WT, int ldt, int drow0, int kdst0, float* scr, int lane) {
#pragma unroll 8
    for (int i = 0; i < 32; ++i) { const int kk = 2 * i + (lane >> 5); scr[kk * 33 + (lane & 31)] = W[(size_t)(k0 + kk) * ldw + n0 + (lane & 31)]; }
    asm volatile("s_waitcnt lgkmcnt(0)" ::: "memory");
    const int c = lane & 7;
#pragma unroll
    for (int j = 0; j < 4; ++j) {
        const int n = (lane >> 3) + 8 * j; const float* s = scr + (8 * c) * 33 + n;
        u32x4 o; o.x = cvt_pk_bf16(s[0 * 33], s[1 * 33]); o.y = cvt_pk_bf16(s[2 * 33], s[3 * 33]); o.z = cvt_pk_bf16(s[4 * 33], s[5 * 33]); o.w = cvt_pk_bf16(s[6 * 33], s[7 * 33]);
        const int di = 16 * ((n >> 2) & 1) + 4 * (n >> 3) + (n & 3);
        *(u32x4*)(WT + (size_t)(drow0 + di) * ldt + kdst0 + k0 + 8 * c) = o;
    }
    asm volatile("s_waitcnt lgkmcnt(0)" ::: "memory");
}

__device__ __forceinline__ void prep_weights(const Frame& F, const Params& P, int l) {
    float* scr = (float*)(F.lds + F.wave * 16384);
    bf16_t* Wb = (bf16_t*)(P.ws + WS_W);
    const float* w_in = P.in[7] + (size_t)l * 1024 * NIN; const float* w_glu = P.in[17] + (size_t)l * 512 * 512; const float* w_br = P.in[21] + (size_t)l * 3 * 512 * 1024;
    const float* w_out = P.in[22] + (size_t)l * 1024 * 1024; const float* w_up = P.in[23] + (size_t)l * 1024 * 5632; const float* w_down = P.in[26] + (size_t)l * 2816 * 1024;
    constexpr int I1 = 16 * 88, I2 = 3 * 16 * 32, I3 = 3 * 8 * 32, I4 = 8 * 16, I5 = 16 * 32, I6 = 16 * 176, I7 = 44 * 32;
    constexpr int NIT = I1 + I2 + I3 + I4 + I5 + I6 + I7;
    const int gw = F.bid * 8 + F.wave, NGW = F.G * 8;
    for (int it = gw; it < NIT; it += NGW) {
        int r = it;
        if (r < I1) { const int kb = r / 88, dg = r % 88, pn = dg >> 3, bj = (dg >> 2) & 1, wc = dg & 3;
            transpose_item(w_in, NIN, 64 * kb, 256 * pn + 64 * wc + 32 * bj, (bf16_t*)((unsigned char*)Wb + W_WIN), 1024, 32 * dg, 0, scr, F.lane); continue; } r -= I1;
        if (r < I2) { const int j = r / 512, rr = r % 512, kb = rr / 32, dg = rr % 32;
            transpose_item(w_in, NIN, 64 * kb, 2816 + 1024 * j + 32 * dg, (bf16_t*)((unsigned char*)Wb + W_BCAT) + (size_t)j * 1024 * 1536, 1536, 32 * dg, 0, scr, F.lane); continue; } r -= I2;
        if (r < I3) { const int j = r / 256, rr = r % 256, kb = rr / 32, dg = rr % 32;
            transpose_item(w_br + (size_t)j * 512 * 1024, 1024, 64 * kb, 32 * dg, (bf16_t*)((unsigned char*)Wb + W_BCAT) + (size_t)j * 1024 * 1536, 1536, 32 * dg, 1024, scr, F.lane); continue; } r -= I3;
        if (r < I4) { const int kb = r / 16, dg = r % 16;
            transpose_item(w_glu, 512, 64 * kb, 32 * dg, (bf16_t*)((unsigned char*)Wb + W_GLU), 512, 32 * dg, 0, scr, F.lane); continue; } r -= I4;
        if (r < I5) { const int kb = r / 32, dg = r % 32;
            transpose_item(w_out, 1024, 64 * kb, 32 * dg, (bf16_t*)((unsigned char*)Wb + W_OUT), 1024, 32 * dg, 0, scr, F.lane); continue; } r -= I5;
        if (r < I6) { const int kb = r / 176, dg = r % 176, pn = dg >> 3, bj = (dg >> 2) & 1, wc = dg & 3;
            transpose_item(w_up, 5632, 64 * kb, bj * 2816 + 128 * pn + 32 * wc, (bf16_t*)((unsigned char*)Wb + W_UP), 1024, 32 * dg, 0, scr, F.lane); continue; } r -= I6;
        { const int kb = r / 32, dg = r % 32;
            transpose_item(w_down, 1024, 64 * kb, 32 * dg, (bf16_t*)((unsigned char*)Wb + W_DOWN), 2816, 32 * dg, 0, scr, F.lane); }
    }
}

__device__ __forceinline__ void prep_s5_part(const Frame& F, const Params& P, int l, int g, int c) {
    float* apr = (float*)F.lds;
    float* api = apr + 2 * 33 * 64;
    float* bbr = api + 2 * 33 * 64;
    float* bbi = bbr + 2 * 64 * 16;
    float* ccr = bbi + 2 * 64 * 16;
    float* cci = ccr + 2 * 64;
    float* Kt = cci + 2 * 64;
    const float* lam_re = P.in[9]; const float* lam_im = P.in[10]; const float* log_dt = P.in[11];
    const float* b_re = P.in[12]; const float* b_im = P.in[13]; const float* c_re = P.in[14]; const float* c_im = P.in[15]; const float* dsk = P.in[16] + l * 512 + g * 16;
    __syncthreads();
    for (int idx = F.tid; idx < 2 * 33 * 64; idx += 512) {
        const int d = idx / (33 * 64), e = (idx / 64) % 33, p = idx % 64; const int gi = (l * 2 + d) * 32 + g;
        const float lr = lam_re[gi * 64 + p], li = lam_im[gi * 64 + p], dt = expf(log_dt[gi]);
        const float mag = expf((float)e * lr * dt), ang = (float)e * li * dt; float sn, cs; sincosf(ang, &sn, &cs);
        apr[idx] = mag * cs; api[idx] = mag * sn;
    }
    if (F.tid < 128) { const int d = F.tid >> 6, p = F.tid & 63; const size_t gi = (size_t)((l * 2 + d) * 32 + g);
        ccr[F.tid] = c_re[(gi * 16 + c) * 64 + p]; cci[F.tid] = c_im[(gi * 16 + c) * 64 + p]; }
    __syncthreads();
    for (int idx = F.tid; idx < 2 * 64 * 16; idx += 512) {
        const int d = idx >> 10, p = (idx >> 4) & 63, c2 = idx & 15; const size_t gi = (size_t)((l * 2 + d) * 32 + g);
        const float lr = lam_re[gi * 64 + p], li = lam_im[gi * 64 + p];
        const float ar = apr[(d * 33 + 1) * 64 + p], ai = api[(d * 33 + 1) * 64 + p], den = lr * lr + li * li;
        const float fr_ = ((ar - 1.0f) * lr + ai * li) / den, fi_ = (ai * lr - (ar - 1.0f) * li) / den;
        const float br = b_re[(gi * 64 + p) * 16 + c2], bi = b_im[(gi * 64 + p) * 16 + c2];
        bbr[idx] = fr_ * br - fi_ * bi; bbi[idx] = fr_ * bi + fi_ * br;
    }
    __syncthreads();
    for (int idx = F.tid; idx < 2 * 32 * 16; idx += 512) {
        const int d = idx >> 9, tau = (idx >> 4) & 31, c2 = idx & 15;
        const float* a_r = apr + (d * 33 + tau) * 64; const float* a_i = api + (d * 33 + tau) * 64;
        const float* c_r = ccr + d * 64; const float* c_i = cci + d * 64;
        const float* b_r = bbr + d * 1024 + c2; const float* b_i = bbi + d * 1024 + c2;
        float sacc = 0.f;
#pragma unroll 4
        for (int p = 0; p < 64; ++p) { const float wr_ = c_r[p] * a_r[p] - c_i[p] * a_i[p], wi_ = c_r[p] * a_i[p] + c_i[p] * a_r[p]; sacc += wr_ * b_r[p * 16] - wi_ * b_i[p * 16]; }
        Kt[idx] = sacc;
    }
    __syncthreads();
    bf16_t* M1 = (bf16_t*)(P.ws + WS_W + W_M1) + (size_t)g * 256 * 512;
    bf16_t* TM2 = (bf16_t*)(P.ws + WS_W + W_TM2) + (size_t)g * 512 * 768;
    for (int v = F.tid; v < 16 * 64; v += 512) {
        const int row = 16 * c + (v >> 6), cv = v & 63, s_ = cv >> 1, c0 = 8 * (cv & 1), d = row >> 7, ri = (row >> 6) & 1, p = row & 63;
        const int e = (d == 0) ? (31 - s_) : s_; const float ar = apr[(d * 33 + e) * 64 + p], ai = api[(d * 33 + e) * 64 + p];
        float o[8];
#pragma unroll
        for (int i = 0; i < 8; ++i) { const float br = bbr[d * 1024 + p * 16 + c0 + i], bi = bbi[d * 1024 + p * 16 + c0 + i]; o[i] = (ri == 0) ? (ar * br - ai * bi) : (ar * bi + ai * br); }
        u32x4 w; w.x = cvt_pk_bf16(o[0], o[1]); w.y = cvt_pk_bf16(o[2], o[3]); w.z = cvt_pk_bf16(o[4], o[5]); w.w = cvt_pk_bf16(o[6], o[7]);
        *(u32x4*)(M1 + (size_t)row * 512 + cv * 8) = w;
    }
    for (int v = F.tid; v < 32 * 96; v += 512) {
        const int t = v / 96, cv = v % 96, row = t * 16 + c;
        float o[8];
        if (cv < 64) {
            const int s_ = cv >> 1, c0 = 8 * (cv & 1);
#pragma unroll
            for (int i = 0; i < 8; ++i) {
                float val = 0.f;
                if (t >= s_) val += Kt[(0 * 32 + (t - s_)) * 16 + c0 + i];
                if (s_ >= t) val += Kt[(1 * 32 + (s_ - t)) * 16 + c0 + i];
                if (t == s_ && c == c0 + i) val += dsk[c];
                o[i] = val;
            }
        } else {
            const int kk = (cv - 64) * 8, d = kk >> 7, ri = (kk >> 6) & 1, p0 = kk & 63, e = (d == 0) ? (t + 1) : (32 - t);
#pragma unroll
            for (int i = 0; i < 8; ++i) {
                const int p = p0 + i; const float cr = ccr[d * 64 + p], ci = cci[d * 64 + p], ar = apr[(d * 33 + e) * 64 + p], ai = api[(d * 33 + e) * 64 + p];
                o[i] = (ri == 0) ? (cr * ar - ci * ai) : -(cr * ai + ci * ar);
            }
        }
        u32x4 w; w.x = cvt_pk_bf16(o[0], o[1]); w.y = cvt_pk_bf16(o[2], o[3]); w.z = cvt_pk_bf16(o[4], o[5]); w.w = cvt_pk_bf16(o[6], o[7]);
        *(u32x4*)(TM2 + (size_t)row * 768 + cv * 8) = w;
    }
    __syncthreads();
}

__device__ __forceinline__ void prep_layer(const Frame& F, const Params& P, int l) {
    for (int it = F.bid; it < 512; it += F.G) prep_s5_part(F, P, l, it >> 4, it & 15);
    __syncthreads();
    prep_weights(F, P, l);
}

__device__ __forceinline__ void phase_adaln(const Frame& F, const Params& P) {
    float* MOD = (float*)(P.ws + WS_MOD); float* TAB = (float*)(P.ws + WS_TAB);
    const float* cvec = P.in[1]; const float* cctx = P.in[3]; const float* w_ada = P.in[4]; const float* b_ada = P.in[5];
    float* sl = (float*)F.lds;
    for (int i = F.tid; i < 5 * 1024; i += 512) { const float cv = (i < 4096) ? cvec[i] : cctx[i - 4096]; sl[i] = cv / (1.0f + __expf(-cv)); }
    __syncthreads();
    for (int it = F.bid; it < 768; it += F.G) {
        const int l = it / 384, r = it % 384, cb = r / 16, ks = r % 16;
        const int col = cb * 256 + (F.tid & 255), kh = F.tid >> 8, kbeg = ks * 64 + kh * 32;
        float a[5] = {0.f, 0.f, 0.f, 0.f, 0.f};
#pragma unroll 8
        for (int k = kbeg; k < kbeg + 32; ++k) {
            const float w = w_ada[((size_t)l * 1024 + k) * 6144 + col];
#pragma unroll
            for (int mb = 0; mb < 5; ++mb) a[mb] += sl[mb * 1024 + k] * w;
        }
        const float bias = (ks == 0 && kh == 0) ? b_ada[l * 6144 + col] : 0.f;
#pragma unroll
        for (int mb = 0; mb < 5; ++mb) atomicAdd(&MOD[(l * 5 + mb) * 6144 + col], a[mb] + bias);
    }
    const int gt = F.bid * 512 + F.tid;
    if (gt < 2048) {
        const int p = gt >> 4, i = gt & 15;
        const float invf = exp2f(-(float)i * (13.287712379549449f / 16.0f)); const float ang = (float)p * invf;
        float sn, cs; sincosf(ang, &sn, &cs);
        TAB[gt * 2] = cs; TAB[gt * 2 + 1] = sn;
    }
}

__device__ __forceinline__ void phase_norm(const Frame& F, const Params& P, int l, int which, int nrows, bf16_t* HB) {
    const float* xl = (l == 0 && which == 0) ? P.in[0] : P.out; const float* xc = (l == 0 && which == 0) ? P.in[2] : (const float*)(P.ws + WS_XC);
    const float* gn = P.in[6] + (l * 2 + which) * 1024; const float* MOD = (const float*)(P.ws + WS_MOD) + l * 5 * 6144;
    bf16_t* H = (bf16_t*)(P.ws + WS_H);
    const int gw = F.bid * 8 + F.wave, NGW = F.G * 8;
    const int nblk = (NLAT >> 4) + (nrows > NLAT ? nrows - NLAT : 0);
    for (int blk = gw; blk < nblk; blk += NGW) {
      const int r0 = (blk < (NLAT >> 4)) ? (blk << 4) : NLAT + (blk - (NLAT >> 4)), nr = (blk < (NLAT >> 4)) ? 16 : 1, mb = (r0 < NLAT) ? (r0 >> 13) : 4;
      const float* sh = MOD + mb * 6144 + (which ? 3072 : 0); const float* sc = sh + 1024;
      f32x4 gsv[4], shv[4];
#pragma unroll
      for (int j = 0; j < 4; ++j) { const int col = 4 * F.lane + 256 * j; gsv[j] = *(const f32x4*)(gn + col) * (*(const f32x4*)(sc + col) + 1.0f); shv[j] = *(const f32x4*)(sh + col); }
#pragma unroll 2
      for (int rr = 0; rr < nr; ++rr) {
        const int row = r0 + rr;
        const float* xr = (row < NLAT) ? xl + (size_t)row * 1024 : xc + (size_t)(row - NLAT) * 1024;
        f32x4 v[4]; float ss = 0.f;
#pragma unroll
        for (int j = 0; j < 4; ++j) v[j] = *(const f32x4*)(xr + 4 * F.lane + 256 * j);
        if (l == 0 && which == 1 && row >= NLAT) {
            const float* cin = P.in[2] + (size_t)(row - NLAT) * 1024 + 4 * F.lane;
            const float* pp = (const float*)(P.ws + WS_AR + AR_PG4) + (size_t)(row - NLAT) * 1024 + 4 * F.lane;
            float* xo = (float*)(P.ws + WS_XC) + (size_t)(row - NLAT) * 1024 + 4 * F.lane;
#pragma unroll
            for (int j = 0; j < 4; ++j) {
                v[j] = *(const f32x4*)(cin + 256 * j);
#pragma unroll
                for (int kp = 0; kp < 3; ++kp) v[j] += *(const f32x4*)(pp + (size_t)kp * NCTX * 1024 + 256 * j);
                *(f32x4*)(xo + 256 * j) = v[j];
            }
        }
        if (l == 1 && which == 0 && row >= NLAT) {
            const float* pp = (const float*)(P.ws + WS_AR + AR_PART) + (size_t)(row - NLAT) * 1024 + 4 * F.lane;
#pragma unroll
            for (int kp = 0; kp < 4; ++kp)
#pragma unroll
                for (int j = 0; j < 4; ++j) v[j] += *(const f32x4*)(pp + (size_t)kp * NCTX * 1024 + 256 * j);
        }
#pragma unroll
        for (int j = 0; j < 4; ++j) ss += (v[j][0] * v[j][0] + v[j][1] * v[j][1]) + (v[j][2] * v[j][2] + v[j][3] * v[j][3]);
        ss = wave_sum(ss); const float rinv = rsqrtf(ss * (1.0f / 1024.0f) + EPS);
#pragma unroll
        for (int j = 0; j < 4; ++j) {
            const int col = 4 * F.lane + 256 * j;
            const f32x4 y = v[j] * rinv * gsv[j] + shv[j];
            u32x2 w; w.x = cvt_pk_bf16(y[0], y[1]); w.y = cvt_pk_bf16(y[2], y[3]);
            *(u32x2*)(H + (size_t)row * 1024 + col) = w;
            if (HB && (((row + 2) & 127) < 4)) *(u32x2*)(HB + (size_t)(4 * ((row + 2) >> 7) + ((row + 2) & 127)) * 1024 + col) = w;
        }
      }
    }
}

__device__ __forceinline__ void phase_scan(const Frame& F, const Params& P, int l) {
    const float* S = (const float*)(P.ws + WS_AR + AR_S); bf16_t* UC = (bf16_t*)(P.ws + WS_AR + AR_UC);
    const float* lam_re = P.in[9]; const float* lam_im = P.in[10]; const float* log_dt = P.in[11];
    const int gw = F.bid * 8 + F.wave, NGW = F.G * 8;
    for (int ww = gw; ww < 256; ww += NGW) {
        const int g = ww >> 3, b = (ww >> 1) & 3, d = ww & 1, p = F.lane; const int gi = (l * 2 + d) * 32 + g;
        const float lr = lam_re[gi * 64 + p], li = lam_im[gi * 64 + p], dt = expf(log_dt[gi]);
        const float mag = expf(32.0f * lr * dt); float sn, cs; sincosf(32.0f * li * dt, &sn, &cs);
        const float aLr = mag * cs, aLi = mag * sn;
        const int ctxb = (NLAT + 256 * b) / 32, latb = 256 * b;
        float cr = 0.f, ci = 0.f;
        auto chunk_of = [&](int j) -> int { return (j < 8) ? (ctxb + (d ? 7 - j : j)) : (latb + (d ? 255 - (j - 8) : (j - 8))); };
        float sr[8], si[8], nr_[8], ni_[8];
#pragma unroll
        for (int q = 0; q < 8; ++q) { const float* sp = S + ((size_t)g * CHPAD + chunk_of(q)) * 256 + d * 128 + p; sr[q] = sp[0]; si[q] = sp[64]; }
        for (int j0 = 0; j0 < 264; j0 += 8) {
            if (j0 + 8 < 264) {
#pragma unroll
                for (int q = 0; q < 8; ++q) { const float* sp = S + ((size_t)g * CHPAD + chunk_of(j0 + 8 + q)) * 256 + d * 128 + p; nr_[q] = sp[0]; ni_[q] = sp[64]; }
            }
#pragma unroll
            for (int q = 0; q < 8; ++q) {
                bf16_t* cp = UC + ((size_t)g * CHPAD + chunk_of(j0 + q)) * 768 + 512 + d * 128 + p;
                cp[0] = (bf16_t)(cvt_pk_bf16(cr, 0.f) & 0xffffu); cp[64] = (bf16_t)(cvt_pk_bf16(ci, 0.f) & 0xffffu);
                const float nr = aLr * cr - aLi * ci + sr[q], ni = aLr * ci + aLi * cr + si[q]; cr = nr; ci = ni;
            }
#pragma unroll
            for (int q = 0; q < 8; ++q) { sr[q] = nr_[q]; si[q] = ni_[q]; }
        }
    }
}

__device__ __forceinline__ s16x4 ld_tr(const unsigned char* p) { return __builtin_bit_cast(s16x4, __builtin_amdgcn_ds_read_tr16_b64_v4i16((LAS s16x4*)p)); }

template <int DV>
__device__ __forceinline__ void attn_pass(const int tid, unsigned char* smem, const bf16_t* Q0, int qpitch, const bf16_t* Kb, int kpitch, const bf16_t* Vb, int vpitch,
                                          int b, int ntiles, float kmax, f32x16 (&o)[DV / 32], float& linv) {
    constexpr int KP = 144, VP = DV * 2 + 64, KBYTES = 64 * KP, VBYTES = 64 * VP, BUF = KBYTES + VBYTES, NV = DV / 64;
    const int lane = tid & 63, wid = __builtin_amdgcn_readfirstlane(tid >> 6), r32 = lane & 31, hi = lane >> 5;
    bf16x8 qf[4];
    { const bf16_t* qp = Q0 + (size_t)(wid * 32 + r32) * qpitch + 8 * hi;
#pragma unroll
      for (int ds = 0; ds < 4; ++ds) qf[ds] = *(const bf16x8*)(qp + 16 * ds); }
    float ssq = 0.f;
#pragma unroll
    for (int ds = 0; ds < 4; ++ds)
#pragma unroll
        for (int j = 0; j < 8; ++j) { const float f = bf2f((unsigned short)qf[ds][j]); ssq += f * f; }
    ssq = sum_x32(ssq);
    const float nshift = -sqrtf(ssq) * kmax;
#pragma unroll
    for (int d0 = 0; d0 < DV / 32; ++d0)
#pragma unroll
        for (int r = 0; r < 16; ++r) o[d0][r] = 0.f;
    float lsum = 0.f;
    const int krow = tid >> 3, kch = tid & 7;
    u32x4 kreg, vreg[NV];
    auto tile_row = [&](int kt) -> size_t { return kt < 4 ? (size_t)(NLAT + 256 * b + 64 * kt) : (size_t)(SEQ * b + 64 * (kt - 4)); };
    auto gload = [&](int kt) {
        const size_t rb = tile_row(kt);
        kreg = *(const u32x4*)(Kb + (rb + krow) * kpitch + 8 * kch);
#pragma unroll
        for (int i = 0; i < NV; ++i) { const int item = tid + 512 * i; const int vr = (DV == 64) ? (item >> 3) : (item >> 4), vc = (DV == 64) ? (item & 7) : (item & 15);
            vreg[i] = *(const u32x4*)(Vb + (rb + vr) * vpitch + 8 * vc); }
    };
    auto lwrite = [&](int buf) {
        unsigned char* Ks = smem + buf * BUF; unsigned char* Vs = Ks + KBYTES;
        *(u32x4*)(Ks + krow * KP + 16 * kch) = kreg;
#pragma unroll
        for (int i = 0; i < NV; ++i) { const int item = tid + 512 * i; const int vr = (DV == 64) ? (item >> 3) : (item >> 4), vc = (DV == 64) ? (item & 7) : (item & 15);
            *(u32x4*)(Vs + vr * VP + 16 * vc) = vreg[i]; }
    };
    gload(0); lwrite(0); __syncthreads();
    const int nhalf = (lane >> 4) & 1, q4 = (lane & 15) >> 2, p4 = lane & 3;
    for (int kt = 0; kt < ntiles; ++kt) {
        if (kt + 1 < ntiles) gload(kt + 1);
        const unsigned char* Ks = smem + (kt & 1) * BUF; const unsigned char* Vs = Ks + KBYTES;
        const unsigned char* kp = Ks + r32 * KP + hi * 16;
        bf16x8 pf[2][2];
#pragma unroll
        for (int kb = 0; kb < 2; ++kb) {
            f32x16 s;
#pragma unroll
            for (int r = 0; r < 16; ++r) s[r] = nshift;
#pragma unroll
            for (int ds = 0; ds < 4; ++ds) {
                const bf16x8 kf = *(const bf16x8*)(kp + kb * 32 * KP + ds * 32);
                s = __builtin_amdgcn_mfma_f32_32x32x16_bf16(kf, qf[ds], s, 0, 0, 0);
            }
            float ls = 0.f;
#pragma unroll
            for (int r = 0; r < 16; ++r) { s[r] = __builtin_amdgcn_exp2f(s[r]); ls += s[r]; }
            lsum += ls;
#pragma unroll
            for (int j = 0; j < 2; ++j) {
                u32x4 w0;
                w0.x = cvt_pk_bf16(s[8 * j + 0], s[8 * j + 1]); w0.y = cvt_pk_bf16(s[8 * j + 2], s[8 * j + 3]); w0.z = cvt_pk_bf16(s[8 * j + 4], s[8 * j + 5]); w0.w = cvt_pk_bf16(s[8 * j + 6], s[8 * j + 7]);
                pf[kb][j] = __builtin_bit_cast(bf16x8, w0);
            }
        }
        const unsigned char* vp = Vs + (4 * hi + q4) * VP + (16 * nhalf + 4 * p4) * 2;
#pragma unroll
        for (int d0 = 0; d0 < DV / 32; ++d0) {
#pragma unroll
            for (int kb = 0; kb < 2; ++kb)
#pragma unroll
                for (int j = 0; j < 2; ++j) {
                    const unsigned char* a = vp + (32 * kb + 16 * j) * VP + d0 * 64;
                    const s16x4 lo = ld_tr(a), h4 = ld_tr(a + 8 * VP);
                    const bf16x8 vf = (bf16x8){lo[0], lo[1], lo[2], lo[3], h4[0], h4[1], h4[2], h4[3]};
                    o[d0] = __builtin_amdgcn_mfma_f32_32x32x16_bf16(vf, pf[kb][j], o[d0], 0, 0, 0);
                }
            if (d0 & 1) __builtin_amdgcn_sched_barrier(0);
        }
        if (kt + 1 < ntiles) lwrite((kt + 1) & 1);
        __syncthreads();
    }
    lsum = sum_x32(lsum);
    linv = 1.0f / lsum;
}

__device__ __forceinline__ void attn_pass_A2(const int tid, unsigned char* smem, const bf16_t* Q0w, int qpitch, const bf16_t* Kb, int kpitch, const bf16_t* Vb, int vpitch,
                                             int b, int ntiles, float kmax, f32x16 (&o)[2][2], float (&linv)[2]) {
    constexpr int KP = 144, VP = 192, KBYTES = 64 * KP, VBYTES = 64 * VP, BUF = KBYTES + VBYTES;
    const int lane = tid & 63, r32 = lane & 31, hi = lane >> 5;
    float nshift[2], lsum[2] = {0.f, 0.f};
    unsigned char* qs = smem + 2 * BUF + ((tid >> 6) * 64 + r32) * KP + hi * 16;
#pragma unroll
    for (int qb = 0; qb < 2; ++qb) {
        const bf16_t* qp = Q0w + (size_t)(32 * qb + r32) * qpitch + 8 * hi; float ssq = 0.f;
#pragma unroll
        for (int ds = 0; ds < 4; ++ds) { const bf16x8 qv = *(const bf16x8*)(qp + 16 * ds); *(bf16x8*)(qs + qb * 32 * KP + ds * 32) = qv;
#pragma unroll
            for (int j = 0; j < 8; ++j) { const float f = bf2f((unsigned short)qv[j]); ssq += f * f; } }
        nshift[qb] = -sqrtf(sum_x32(ssq)) * kmax;
#pragma unroll
        for (int d0 = 0; d0 < 2; ++d0)
#pragma unroll
            for (int r = 0; r < 16; ++r) o[qb][d0][r] = 0.f;
    }
    const int krow = tid >> 3, kch = tid & 7;
    u32x4 kreg, vreg;
    auto gload = [&](int kt) {
        const size_t rb = kt < 4 ? (size_t)(NLAT + 256 * b + 64 * kt) : (size_t)(SEQ * b + 64 * (kt - 4));
        kreg = *(const u32x4*)(Kb + (rb + krow) * kpitch + 8 * kch); vreg = *(const u32x4*)(Vb + (rb + krow) * vpitch + 8 * kch);
    };
    auto lwrite = [&](int buf) { unsigned char* Ks = smem + buf * BUF; *(u32x4*)(Ks + krow * KP + 16 * kch) = kreg; *(u32x4*)(Ks + KBYTES + krow * VP + 16 * kch) = vreg; };
    gload(0); lwrite(0); __syncthreads();
    const int nhalf = (lane >> 4) & 1, q4 = (lane & 15) >> 2, p4 = lane & 3;
    for (int kt = 0; kt < ntiles; ++kt) {
        if (kt + 1 < ntiles) gload(kt + 1);
        const unsigned char* Ks = smem + (kt & 1) * BUF; const unsigned char* Vs = Ks + KBYTES;
        const unsigned char* kp = Ks + r32 * KP + hi * 16;
        const unsigned char* vp = Vs + (4 * hi + q4) * VP + (16 * nhalf + 4 * p4) * 2;
#pragma unroll
        for (int kb = 0; kb < 2; ++kb) {
            bf16x8 pf[2][2];
            {
                f32x16 s0, s1;
#pragma unroll
                for (int r = 0; r < 16; ++r) { s0[r] = nshift[0]; s1[r] = nshift[1]; }
#pragma unroll
                for (int ds = 0; ds < 4; ++ds) {
                    const bf16x8 kf = *(const bf16x8*)(kp + kb * 32 * KP + ds * 32);
                    const bf16x8 q0 = *(const bf16x8*)(qs + ds * 32), q1 = *(const bf16x8*)(qs + 32 * KP + ds * 32);
                    s0 = __builtin_amdgcn_mfma_f32_32x32x16_bf16(kf, q0, s0, 0, 0, 0);
                    s1 = __builtin_amdgcn_mfma_f32_32x32x16_bf16(kf, q1, s1, 0, 0, 0);
                }
                float l0 = 0.f, l1 = 0.f;
#pragma unroll
                for (int r = 0; r < 16; ++r) { s0[r] = __builtin_amdgcn_exp2f(s0[r]); l0 += s0[r]; }
#pragma unroll
                for (int r = 0; r < 16; ++r) { s1[r] = __builtin_amdgcn_exp2f(s1[r]); l1 += s1[r]; }
                lsum[0] += l0; lsum[1] += l1;
#pragma unroll
                for (int j = 0; j < 2; ++j) {
                    u32x4 w0, w1;
                    w0.x = cvt_pk_bf16(s0[8 * j + 0], s0[8 * j + 1]); w0.y = cvt_pk_bf16(s0[8 * j + 2], s0[8 * j + 3]); w0.z = cvt_pk_bf16(s0[8 * j + 4], s0[8 * j + 5]); w0.w = cvt_pk_bf16(s0[8 * j + 6], s0[8 * j + 7]);
                    w1.x = cvt_pk_bf16(s1[8 * j + 0], s1[8 * j + 1]); w1.y = cvt_pk_bf16(s1[8 * j + 2], s1[8 * j + 3]); w1.z = cvt_pk_bf16(s1[8 * j + 4], s1[8 * j + 5]); w1.w = cvt_pk_bf16(s1[8 * j + 6], s1[8 * j + 7]);
                    pf[0][j] = __builtin_bit_cast(bf16x8, w0); pf[1][j] = __builtin_bit_cast(bf16x8, w1);
                }
            }
#pragma unroll
            for (int d0 = 0; d0 < 2; ++d0)
#pragma unroll
                for (int j = 0; j < 2; ++j) {
                    const unsigned char* a = vp + (32 * kb + 16 * j) * VP + d0 * 64;
                    const s16x4 lo = ld_tr(a), h4 = ld_tr(a + 8 * VP);
                    const bf16x8 vf = (bf16x8){lo[0], lo[1], lo[2], lo[3], h4[0], h4[1], h4[2], h4[3]};
                    o[0][d0] = __builtin_amdgcn_mfma_f32_32x32x16_bf16(vf, pf[0][j], o[0][d0], 0, 0, 0);
                    o[1][d0] = __builtin_amdgcn_mfma_f32_32x32x16_bf16(vf, pf[1][j], o[1][d0], 0, 0, 0);
                }
            __builtin_amdgcn_sched_barrier(0);
        }
        if (kt + 1 < ntiles) lwrite((kt + 1) & 1);
        __syncthreads();
    }
    linv[0] = 1.0f / sum_x32(lsum[0]); linv[1] = 1.0f / sum_x32(lsum[1]);
}

__device__ __forceinline__ void attn_unit_A2(const Frame& F, const Params& P, int l, int b, int h, size_t qrow0, int nq, int ntiles, float kmax, size_t ooff) {
    bf16_t* YAB = (bf16_t*)(P.ws + WS_AR + AR_YAB); const bf16_t* KA = (const bf16_t*)(P.ws + WS_AR + AR_KA); const bf16_t* VA = (const bf16_t*)(P.ws + WS_AR + AR_VA);
    f32x16 o[2][2]; float linv[2];
    { const int wrow = (F.wave * 64 < nq) ? F.wave * 64 : (F.wave - 4) * 64;
      attn_pass_A2(F.tid, F.lds, YAB + (qrow0 + wrow) * 1024 + 64 * h, 1024, KA + 64 * (h >> 2), 128, VA + 64 * (h >> 2), 128, b, ntiles, kmax, o, linv); }
    int t2 = F.tid; asm volatile("" : "+v"(t2));
    const int r32 = t2 & 31, hi = (t2 >> 5) & 1, wv = t2 >> 6;
    if (wv * 64 < nq) {
#pragma unroll
        for (int qb = 0; qb < 2; ++qb) {
            bf16_t* op = YAB + ooff + (qrow0 + wv * 64 + 32 * qb + r32) * 1024 + 64 * h + 4 * hi;
#pragma unroll
            for (int d0 = 0; d0 < 2; ++d0)
#pragma unroll
                for (int rg = 0; rg < 4; ++rg) {
                    u32x2 w; w.x = cvt_pk_bf16(o[qb][d0][4 * rg] * linv[qb], o[qb][d0][4 * rg + 1] * linv[qb]); w.y = cvt_pk_bf16(o[qb][d0][4 * rg + 2] * linv[qb], o[qb][d0][4 * rg + 3] * linv[qb]);
                    *(u32x2*)(op + 32 * d0 + 8 * rg) = w;
                }
        }
    }
}

__device__ __forceinline__ void attn_unit_C(const Frame& F, const Params& P, int l, int b, int h, size_t qrow0, int ntiles, float kmax, size_t ooff) {
    bf16_t* YD = (bf16_t*)(P.ws + WS_AR + AR_YD); const bf16_t* KC = (const bf16_t*)(P.ws + WS_AR + AR_KC); const bf16_t* VC = (const bf16_t*)(P.ws + WS_AR + AR_VC);
#pragma unroll 1
    for (int sub = 0; sub < 2; ++sub) {
        f32x16 o[4]; float linv;
        attn_pass<128>(F.tid, F.lds, YD + qrow0 * 1024 + 128 * h + 64 * sub, 1024, KC + 128 * h + 64 * sub, 512, VC + 128 * h, 512, b, ntiles, kmax, o, linv);
        int t2 = F.tid; asm volatile("" : "+v"(t2));
        const int r32 = t2 & 31, hi = (t2 >> 5) & 1, wv = t2 >> 6;
        float* st = (float*)(P.ws + WS_AR + AR_O1) + (size_t)F.bid * 32768 + (size_t)t2 * 4;
        if (sub == 0) {
#pragma unroll
            for (int d0 = 0; d0 < 4; ++d0)
#pragma unroll
                for (int rg = 0; rg < 4; ++rg)
                    *(f32x4*)(st + (size_t)(d0 * 4 + rg) * 2048) = (f32x4){o[d0][4 * rg] * linv, o[d0][4 * rg + 1] * linv, o[d0][4 * rg + 2] * linv, o[d0][4 * rg + 3] * linv};
        } else {
            const float* lv = P.in[19] + l * 256 + (t2 & 63);
            const float lam_init = (l == 0) ? 0.2f : 0.35550906f;
            const float lam = expf(wave_sum(lv[0] * lv[64])) - expf(wave_sum(lv[128] * lv[192])) + lam_init;
            const float nl = -lam * linv; float ss = 0.f;
#pragma unroll
            for (int d0 = 0; d0 < 4; ++d0)
#pragma unroll
                for (int rg = 0; rg < 4; ++rg) {
                    const f32x4 s1 = *(const f32x4*)(st + (size_t)(d0 * 4 + rg) * 2048);
#pragma unroll
                    for (int e = 0; e < 4; ++e) { const float dd = s1[e] + nl * o[d0][4 * rg + e]; o[d0][4 * rg + e] = dd; ss += dd * dd; }
                }
            ss = sum_x32(ss);
            const float rn = rsqrtf(ss * (1.0f / 128.0f) + EPS) * (1.0f - lam_init);
            const float* go = P.in[20] + l * 128;
            bf16_t* op = YD + ooff + (qrow0 + wv * 32 + r32) * 1024 + 128 * h + 4 * hi;
#pragma unroll
            for (int d0 = 0; d0 < 4; ++d0)
#pragma unroll
                for (int rg = 0; rg < 4; ++rg) {
                    const f32x4 gv = *(const f32x4*)(go + 32 * d0 + 8 * rg + 4 * hi);
                    u32x2 w; w.x = cvt_pk_bf16(o[d0][4 * rg] * rn * gv[0], o[d0][4 * rg + 1] * rn * gv[1]); w.y = cvt_pk_bf16(o[d0][4 * rg + 2] * rn * gv[2], o[d0][4 * rg + 3] * rn * gv[3]);
                    *(u32x2*)(op + 32 * d0 + 8 * rg) = w;
                }
        }
    }
}

__device__ __forceinline__ void phase_attn(const Frame& F0, const Params& P, int l, size_t ooffA, size_t ooffC) {
    const int total = (l == 0) ? 1072 : 1024;
    for (int i = F0.bid; i < total; i += F0.G) {
        Frame F = F0; { int t = F0.tid; asm volatile("" : "+v"(t)); F.tid = t; F.lane = t & 63; F.wave = __builtin_amdgcn_readfirstlane(t >> 6); }
        int isC, b, h, nt, nq; size_t qrow0;
        if (i < 512) { const int combo = ((i >> 8) << 3) | (i & 7), qb = (i >> 3) & 31; isC = 1; b = combo >> 2; h = combo & 3; qrow0 = (size_t)b * SEQ + 256 * qb; nt = 132; nq = 256; }
        else if (i < 1024) { const int u = i - 512, w = u & 255, slot = w >> 3, combo = (u >> 8) * 16 + (w & 7) * 2 + (slot >> 4); isC = 0; b = combo >> 3; h = combo & 7; qrow0 = (size_t)b * SEQ + 512 * (slot & 15); nt = 132; nq = 512; }
        else { const int u = i - 1024, r = u % 12; b = u / 12; isC = r < 4; h = isC ? r : r - 4; qrow0 = (size_t)NLAT + 256 * b; nt = 4; nq = 256; }
        const float kmax = 8.08f * wave_max(fabsf(P.in[8][(l * 4 + (isC ? 3 : 1)) * 64 + F.lane]));
        if (isC) attn_unit_C(F, P, l, b, h, qrow0, nt, kmax, ooffC); else attn_unit_A2(F, P, l, b, h, qrow0, nq, nt, kmax, ooffA);
    }
}

__device__ __forceinline__ void phase_fixup(const Frame& F, const Params& P, int l, int nrows) {
    const bf16_t* UB = (const bf16_t*)(P.ws + WS_AR + AR_UB); bf16_t* ACT = (bf16_t*)(P.ws + WS_AR + AR_ACT);
    const float* cw = P.in[24] + (size_t)l * 3 * 5632; const float* cb = P.in[25] + (size_t)l * 5632;
    const int nitems = NBGRP * 2 * 352;
    for (int it = F.bid * 512 + F.tid; it < nitems; it += F.G * 512) {
        const int fc = it % 352, js = it / 352, j = js >> 1, sd = js & 1, f0 = 8 * fc;
        const int row = 128 * j - 1 + sd;
        if (row < 0 || row >= nrows) continue;
        const int tpos = (row < NLAT) ? (row & (SEQ - 1)) : ((row - NLAT) & (CTXL - 1)), seqlen = (row < NLAT) ? SEQ : CTXL;
        const int ca = 256 * (f0 >> 7) + (f0 & 127);
        const bf16_t* ub = UB + (size_t)(4 * j + sd) * 5632 + ca;
        const u32x4 z = (u32x4){0, 0, 0, 0};
        const u32x4 pa = (tpos > 0) ? *(const u32x4*)(ub) : z, pg = (tpos > 0) ? *(const u32x4*)(ub + 128) : z;
        const u32x4 ca_ = *(const u32x4*)(ub + 5632), cg_ = *(const u32x4*)(ub + 5632 + 128);
        const u32x4 na = (tpos + 1 < seqlen) ? *(const u32x4*)(ub + 11264) : z, ng = (tpos + 1 < seqlen) ? *(const u32x4*)(ub + 11264 + 128) : z;
        float o[8];
#pragma unroll
        for (int i = 0; i < 4; ++i) {
            const int c0 = f0 + 2 * i, c1 = c0 + 1;
            const float a0 = bflo(pa[i]) * cw[c0] + bflo(ca_[i]) * cw[5632 + c0] + bflo(na[i]) * cw[11264 + c0] + cb[c0];
            const float a1 = bfhi(pa[i]) * cw[c1] + bfhi(ca_[i]) * cw[5632 + c1] + bfhi(na[i]) * cw[11264 + c1] + cb[c1];
            const float g0 = bflo(pg[i]) * cw[2816 + c0] + bflo(cg_[i]) * cw[5632 + 2816 + c0] + bflo(ng[i]) * cw[11264 + 2816 + c0] + cb[2816 + c0];
            const float g1 = bfhi(pg[i]) * cw[2816 + c1] + bfhi(cg_[i]) * cw[5632 + 2816 + c1] + bfhi(ng[i]) * cw[11264 + 2816 + c1] + cb[2816 + c1];
            o[2 * i] = g0 * sigmoidf_(g0) * a0; o[2 * i + 1] = g1 * sigmoidf_(g1) * a1;
        }
        u32x4 w; w.x = cvt_pk_bf16(o[0], o[1]); w.y = cvt_pk_bf16(o[2], o[3]); w.z = cvt_pk_bf16(o[4], o[5]); w.w = cvt_pk_bf16(o[6], o[7]);
        *(u32x4*)(ACT + (size_t)row * 2816 + f0) = w;
    }
}

#ifndef PH_MASK
#define PH_MASK 0x1ffff
#endif
#define PHM(k) ((PH_MASK >> (k)) & 1)
#ifndef REP_MASK
#define REP_MASK 0
#endif
constexpr int NPHASE = 33;
constexpr int LDS_BYTES = 147456;

__global__ void __launch_bounds__(512, 2) mega_fwd(Params P) {
    extern __shared__ __attribute__((aligned(16))) unsigned char lds[];
    cg::grid_group grid = cg::this_grid();
    const int wave_s = __builtin_amdgcn_readfirstlane(threadIdx.x >> 6);
    volatile LAS unsigned* bst = (volatile LAS unsigned*)((LAS unsigned char*)lds + 131072 + 1024);
    if (threadIdx.x < 2) bst[threadIdx.x] = 0u;
    __syncthreads();
    (void)xcd_barrier_post((unsigned*)(P.ws + WS_BAR), bst);
    for (int ph = P.ph_lo; ph < P.ph_hi; ++ph) {
        if (ph > 0 && (((ph - 1) & 15) >= 13 || ((ph - 1) & 15) == 5 || ((ph - 1) & 15) == 11)) continue;
        const int nrep = (ph > 0 && P.rep_q == ((ph - 1) & 15)) ? P.rep_n + 1 : 1;
        for (int rep = 0; rep < nrep; ++rep) {
        int tid_l = wave_s * 64 + (int)__builtin_amdgcn_mbcnt_hi(~0u, __builtin_amdgcn_mbcnt_lo(~0u, 0u)), bid_l = blockIdx.x, g_l = gridDim.x; unsigned char* ws = P.ws;
        asm volatile("" : "+v"(tid_l)); asm volatile("" : "+s"(bid_l), "+s"(g_l), "+s"(ws));
        Frame F; F.lds = lds; F.tid = tid_l; F.lane = F.tid & 63; F.wave = __builtin_amdgcn_readfirstlane(F.tid >> 6); F.G = g_l; F.bid = bid_l;
        LAS unsigned char* ldsl = (LAS unsigned char*)lds;
        unsigned char* AR = ws + WS_AR; unsigned char* Wb = ws + WS_W;
        bf16_t* H = (bf16_t*)(ws + WS_H); float* XC = (float*)(ws + WS_XC); const float* MODall = (const float*)(ws + WS_MOD);
        if (ph == 0) {
            if (PHM(16)) { phase_adaln(F, P); prep_layer(F, P, 0); }
        } else {
            const int l = (ph - 1) >> 4, q = (ph - 1) & 15; const bool last = (l == 1);
            const float* MOD = MODall + l * 5 * 6144;
            const int nM_out = last ? 128 : 132;
            switch (q) {
            case 0: if (PHM(0)) { phase_norm(F, P, l, 0, MT, nullptr); if (l == 1) prep_layer(F, P, 1); } break;
            case 1: if (PHM(1)) {
                SchedPlain S{H, (const bf16_t*)(Wb + W_WIN), 1024, 1024, 132, 11, 16, F.G, F.bid, 0};
                EpiG1 E{(bf16_t*)(AR + AR_YAB), (bf16_t*)(AR + AR_YD), (bf16_t*)(AR + AR_KA), (bf16_t*)(AR + AR_VA), (bf16_t*)(AR + AR_KC), (bf16_t*)(AR + AR_VC), (bf16_t*)(AR + AR_UC),
                        P.in[8] + l * 256, (const float*)(ws + WS_TAB)};
                pg8::gemm_phase<EpiG1, SchedPlain, true, true>(ldsl, F.tid, 1024, 1024, S, E);
            } break;
            case 2: if (PHM(2)) {
                SchedS5 S{(const bf16_t*)(AR + AR_UC), (const bf16_t*)(Wb + W_M1), 512, 1, 8, F.G, F.bid, 5};
                EpiS E{(float*)(AR + AR_S)};
                pg8::gemm_phase<EpiS, SchedS5, true, true>(ldsl, F.tid, 768, 512, S, E);
            } break;
            case 3: if (PHM(3)) phase_scan(F, P, l); break;
            case 4: if (PHM(4)) {
                SchedS5 S{(const bf16_t*)(AR + AR_UC), (const bf16_t*)(Wb + W_TM2), 768, 2, 12, F.G, F.bid, last ? 4 : 5};
                EpiY E{(bf16_t*)(AR + AR_YD) + 512};
                pg8::gemm_phase<EpiY, SchedS5, true, true>(ldsl, F.tid, 768, 768, S, E);
            } break;
            case 6: if (PHM(6)) {
                {

                SchedPlain S{(const bf16_t*)(AR + AR_YD) + 512, (const bf16_t*)(Wb + W_GLU), 1024, 512, nM_out, 2, 8, F.G, F.bid, 0};
                EpiGLU E{(const bf16_t*)(AR + AR_YD) + 512, (bf16_t*)(AR + AR_YAB) + 512, P.in[18] + l * 512};
                pg8::gemm_phase<EpiGLU, SchedPlain, true, true>(ldsl, F.tid, 1024, 512, S, E);
                            }
                const bool dummy = rep + 1 < nrep;
                phase_attn(F, P, l, dummy ? (size_t)(250 * MiB - AR_YAB) / 2 : 0, dummy ? (size_t)(250 * MiB - AR_YD) / 2 : 0);
            } break;
            case 7: if (PHM(7)) {
                SchedMerge S{H, (const bf16_t*)(AR + AR_YAB), (const bf16_t*)(AR + AR_YD), (const bf16_t*)(Wb + W_BCAT), last ? 0 : 48, F.G, F.bid};
                EpiMerge E{(bf16_t*)(AR + AR_M), (float*)(AR + AR_SM) + (size_t)F.bid * 65536, (unsigned*)(AR + AR_SG) + (size_t)F.bid * 32768, F.tid, (bf16_t*)(AR + AR_MCTX)};
                pg8::gemm_phase<EpiMerge, SchedMerge, true, true>(ldsl, F.tid, 1024, 1536, S, E);
            } break;
            case 8: if (PHM(8)) {
                SchedG4 S{(const bf16_t*)(AR + AR_M), (const bf16_t*)(AR + AR_MCTX), (const bf16_t*)(Wb + W_OUT), last ? 0 : 48, F.G, F.bid};
                EpiRes E{l == 0 ? P.in[0] : P.out, l == 0 ? P.in[2] : XC, P.out, XC, MOD, 2048, (float*)(AR + AR_PG4)};
                pg8::gemm_phase<EpiRes, SchedG4, true, true>(ldsl, F.tid, 1024, 1024, S, E);
            } break;
            case 9: if (PHM(9)) phase_norm(F, P, l, 1, last ? NLAT : MT, (bf16_t*)(AR + AR_HB)); break;
            case 10: if (PHM(10)) {
                SchedUp S{H, (const bf16_t*)(AR + AR_HB), (const bf16_t*)(Wb + W_UP), nM_out, F.G, F.bid};
                EpiUpConv E{(bf16_t*)(AR + AR_ACT), last ? NLAT : MT, P.in[24] + (size_t)l * 3 * 5632, P.in[25] + (size_t)l * 5632};
                pg8::gemm_phase<EpiUpConv, SchedUp, true, true, true>(ldsl, F.tid, 1024, 1024, S, E);
            } break;
            case 11: if (PHM(11)) phase_fixup(F, P, l, last ? NLAT : MT); break;
            case 12: if (PHM(12)) {
                EpiRes E{P.out, XC, P.out, XC, MOD, 5120, (float*)(AR + AR_PART)};
                SchedG6c S{(const bf16_t*)(AR + AR_ACT), (const bf16_t*)(Wb + W_DOWN), F.G, F.bid, last ? 0 : 64};
                pg8::gemm_phase<EpiRes, SchedG6c, true, true>(ldsl, F.tid, 2816, 2816, S, E);
            } break;
            default: break;
            }
        }
        if (rep + 1 < nrep) __syncthreads();
        }
        if (ph + 1 < P.ph_hi && ph < NPHASE - 4) { if (ph == P.ph_lo) grid.sync(); else { XcdBarrier xb; xb.bar = (unsigned*)(P.ws + WS_BAR); xb.x = xb_xcc_id(); xb.st = (volatile LAS unsigned*)((LAS unsigned char*)lds + 131072 + 1024); xcd_barrier(xb); } }
    }
}

extern "C" void kernel_launch(void* const* d_in, const int* in_sizes, int n_in, void* d_out, int out_size, void* d_ws, size_t ws_size, hipStream_t stream) {
    static int grid = 0;
    if (grid == 0) {
        int dev = 0, cus = 0, per_cu = 0;
        if (hipGetDevice(&dev) != hipSuccess || hipDeviceGetAttribute(&cus, hipDeviceAttributeMultiprocessorCount, dev) != hipSuccess) { fprintf(stderr, "device query failed\n"); grid = -1; return; }
        if (hipFuncSetAttribute((const void*)mega_fwd, hipFuncAttributeMaxDynamicSharedMemorySize, LDS_BYTES) != hipSuccess) { fprintf(stderr, "hipFuncSetAttribute failed\n"); grid = -1; return; }
        if (hipOccupancyMaxActiveBlocksPerMultiprocessor(&per_cu, (const void*)mega_fwd, 512, LDS_BYTES) != hipSuccess || per_cu < 1) { fprintf(stderr, "occupancy query: %d\n", per_cu); per_cu = 1; }
        (void)hipGetLastError();
        grid = cus > 256 ? 256 : cus;
        if (n_in != 27 || out_size != NLAT * DM || ws_size < WS_TOTAL) { fprintf(stderr, "kernel_launch: unexpected shapes (n_in %d out %d ws %zu need %zu)\n", n_in, out_size, ws_size, (size_t)WS_TOTAL); grid = -1; return; }
    }
    if (grid < 0) return;
    (void)hipMemsetAsync((char*)d_ws + WS_MOD, 0, 512 * 1024, stream);
    Params p{};
    for (int i = 0; i < 27; ++i) p.in[i] = (const float*)d_in[i];
    p.out = (float*)d_out; p.ws = (unsigned char*)d_ws;
    p.rep_q = -1; p.rep_n = 0;
#ifdef PROBE_Q
    p.rep_q = PROBE_Q; p.rep_n = 1;
#endif
#if N_LAUNCH_MODE == 1
    p.ph_lo = 0; p.ph_hi = NPHASE;
    void* args[] = {&p};
    hipError_t e = hipLaunchCooperativeKernel((const void*)mega_fwd, dim3(grid), dim3(512), args, LDS_BYTES, stream);
    if (e != hipSuccess) fprintf(stderr, "cooperative launch failed: %s (grid %d)\n", hipGetErrorString(e), grid);
#else
    for (int ph = 0; ph < NPHASE; ++ph) {
        p.ph_lo = ph; p.ph_hi = ph + 1;
        hipLaunchKernelGGL(mega_fwd, dim3(grid), dim3(512), LDS_BYTES, stream, p);
    }
#endif
}
```
